# Optimizing an MI355X kernel written in HIP

```python
import math
import jax, jax.numpy as jnp
from jax import lax
import numpy as np

D_MODEL = 1024
BATCH = 16
SEQ = 2048
DEPTH = 2

D_MIX = D_MODEL
W_POOL = D_MIX // 4
W_SCONV = D_MIX // 4
W_CONF = D_MIX // 4
W_ATTN = D_MIX // 4
POOL_WINDOWS = (2, 4, 8, 16)
N_POOL_GROUPS = len(POOL_WINDOWS)
POOL_GROUP = W_POOL // N_POOL_GROUPS
SCONV_K = 3
CONF_K = 31
N_HEADS = 4
HEAD_V = W_ATTN // N_HEADS
HEAD_QK = HEAD_V // 2
SPLIT_SIZES = (W_POOL, W_SCONV, W_SCONV, W_SCONV, W_CONF, W_CONF, W_ATTN, W_ATTN, W_ATTN)
D_IN = sum(SPLIT_SIZES)
D_FF = ((8 * D_MODEL + 3 * 256 - 1) // (3 * 256)) * 256
REL_BUCKETS = 32
REL_MAX_EXACT = REL_BUCKETS // 2
REL_MAX_DIST = 128
Q_BLOCK = 128
EPS = 1e-6
NEG_INF = -1e30

kernel_name = 'hybrid_parallel_pool_conv_conformer_diffattn'


def rms_norm(x, g):
    xf = x.astype(jnp.float32)
    y = xf * lax.rsqrt(jnp.mean(xf * xf, axis=-1, keepdims=True) + EPS)
    return (y * g.astype(jnp.float32)).astype(x.dtype)


def layer_norm(x, g, b):
    xf = x.astype(jnp.float32)
    mu = jnp.mean(xf, axis=-1, keepdims=True)
    xc = xf - mu
    y = xc * lax.rsqrt(jnp.mean(xc * xc, axis=-1, keepdims=True) + EPS)
    return (y * g.astype(jnp.float32) + b.astype(jnp.float32)).astype(x.dtype)


def causal_dwconv(u, w):
    k = w.shape[0]
    return lax.conv_general_dilated(
        u, w[:, None, :].astype(u.dtype), window_strides=(1,), padding=[(k - 1, 0)],
        dimension_numbers=('NWC', 'WIO', 'NWC'), feature_group_count=u.shape[-1])


def pool_mixer(u, pool_w, pool_scale):
    b, s, _ = u.shape
    c = jnp.cumsum(u.astype(jnp.float32), axis=1)
    pos1 = jnp.arange(1, s + 1)
    parts = []
    for g, win in enumerate(POOL_WINDOWS):
        cg = c[..., g * POOL_GROUP:(g + 1) * POOL_GROUP]
        shifted = jnp.pad(cg, ((0, 0), (win, 0), (0, 0)))[:, :s]
        cnt = jnp.minimum(pos1, win).astype(jnp.float32)[:, None]
        parts.append((cg - shifted) / cnt)
    pooled = jnp.concatenate(parts, axis=-1).astype(u.dtype) - u
    y = jnp.einsum('bsgc,gcd->bsgd', pooled.reshape(b, s, N_POOL_GROUPS, POOL_GROUP), pool_w)
    return y.reshape(b, s, W_POOL) * pool_scale


def rel_bucket(n):
    nf = jnp.maximum(n, 1).astype(jnp.float32)
    large = REL_MAX_EXACT + (jnp.log(nf / REL_MAX_EXACT) / math.log(REL_MAX_DIST / REL_MAX_EXACT)
                             * (REL_BUCKETS - REL_MAX_EXACT)).astype(jnp.int32)
    large = jnp.minimum(large, REL_BUCKETS - 1)
    return jnp.where(n < REL_MAX_EXACT, n, large)


def diff_attention(q, k, v, q_norm_g, k_norm_g, lam, lam_init, subln_g, rel_bias):
    b, s = q.shape[:2]
    q = rms_norm(q, q_norm_g)
    k = rms_norm(k, k_norm_g)
    scale = HEAD_QK ** -0.5
    nb = s // Q_BLOCK
    qb = q.reshape(b, nb, Q_BLOCK, N_HEADS, 2, HEAD_QK).transpose(1, 0, 2, 3, 4, 5)
    starts = jnp.arange(nb, dtype=jnp.int32) * Q_BLOCK
    kpos = jnp.arange(s, dtype=jnp.int32)

    def block(args):
        qblk, start = args
        qpos = start + jnp.arange(Q_BLOCK, dtype=jnp.int32)
        dist = qpos[:, None] - kpos[None, :]
        bias = rel_bias[rel_bucket(jnp.maximum(dist, 0))].astype(jnp.float32)
        bias = bias.transpose(2, 0, 1)[:, None]
        sc = jnp.einsum('bqhmd,bkhmd->bhmqk', qblk, k).astype(jnp.float32) * scale + bias
        sc = jnp.where(dist >= 0, sc, NEG_INF)
        p = jax.nn.softmax(sc, axis=-1)
        a = p[:, :, 0] - lam * p[:, :, 1]
        return jnp.einsum('bhqk,bkhd->bqhd', a.astype(v.dtype), v)

    o = lax.map(block, (qb, starts))
    o = o.transpose(1, 0, 2, 3, 4).reshape(b, s, N_HEADS, HEAD_V)
    o = rms_norm(o, subln_g) * (1.0 - lam_init)
    return o.reshape(b, s, W_ATTN)


def hybrid_layer(x, norm1_g, w_in, pool_w, pool_scale, sconv_w, conf_dw_w, conf_dw_b,
                 conf_ln_g, conf_ln_b, q_norm_g, k_norm_g, lam_q1, lam_k1, lam_q2, lam_k2,
                 subln_g, w_out, norm2_g, w_gate, w_up, w_down, rel_bias, lam_init):
    b, s, _ = x.shape
    h = rms_norm(x, norm1_g)
    z = h @ w_in
    idx = [int(i) for i in np.cumsum(SPLIT_SIZES)[:-1]]
    z_pool, s_b, s_c, s_h, c_a, c_g, zq, zk, zv = jnp.split(z, idx, axis=-1)
    y_pool = pool_mixer(z_pool, pool_w, pool_scale)
    y_sconv = s_b * causal_dwconv(s_c * s_h, sconv_w)
    u = c_a * jax.nn.sigmoid(c_g)
    u = causal_dwconv(u, conf_dw_w) + conf_dw_b
    y_conf = jax.nn.silu(layer_norm(u, conf_ln_g, conf_ln_b))
    lam = (jnp.exp(jnp.sum(lam_q1.astype(jnp.float32) * lam_k1.astype(jnp.float32)))
           - jnp.exp(jnp.sum(lam_q2.astype(jnp.float32) * lam_k2.astype(jnp.float32))) + lam_init)
    q = zq.reshape(b, s, N_HEADS, 2, HEAD_QK)
    k = zk.reshape(b, s, N_HEADS, 2, HEAD_QK)
    v = zv.reshape(b, s, N_HEADS, HEAD_V)
    y_attn = diff_attention(q, k, v, q_norm_g, k_norm_g, lam, lam_init, subln_g, rel_bias)
    mix = jnp.concatenate([y_pool, y_sconv, y_conf, y_attn], axis=-1)
    x = x + mix @ w_out
    h2 = rms_norm(x, norm2_g)
    x = x + (jax.nn.silu(h2 @ w_gate) * (h2 @ w_up)) @ w_down
    return x


def setup_inputs(seed: int = 0) -> dict:
    key = jax.random.key(seed)
    ks = jax.random.split(key, 24)
    f32 = jnp.float32
    nrm = lambda k, shape, sc: jax.random.normal(k, shape, f32) * sc
    L = DEPTH
    return {
        'x': nrm(ks[0], (BATCH, SEQ, D_MODEL), 1.0),
        'norm1_g': 1.0 + nrm(ks[1], (L, D_MODEL), 0.05),
        'w_in': nrm(ks[2], (L, D_MODEL, D_IN), D_MODEL ** -0.5),
        'pool_w': nrm(ks[3], (L, N_POOL_GROUPS, POOL_GROUP, POOL_GROUP), POOL_GROUP ** -0.5),
        'pool_scale': 1.0 + nrm(ks[4], (L, W_POOL), 0.1),
        'sconv_w': nrm(ks[5], (L, SCONV_K, W_SCONV), SCONV_K ** -0.5),
        'conf_dw_w': nrm(ks[6], (L, CONF_K, W_CONF), CONF_K ** -0.5),
        'conf_dw_b': nrm(ks[7], (L, W_CONF), 0.02),
        'conf_ln_g': 1.0 + nrm(ks[8], (L, W_CONF), 0.05),
        'conf_ln_b': nrm(ks[9], (L, W_CONF), 0.02),
        'q_norm_g': 1.0 + nrm(ks[10], (L, HEAD_QK), 0.05),
        'k_norm_g': 1.0 + nrm(ks[11], (L, HEAD_QK), 0.05),
        'lam_q1': nrm(ks[12], (L, HEAD_QK), 0.1),
        'lam_k1': nrm(ks[13], (L, HEAD_QK), 0.1),
        'lam_q2': nrm(ks[14], (L, HEAD_QK), 0.1),
        'lam_k2': nrm(ks[15], (L, HEAD_QK), 0.1),
        'subln_g': 1.0 + nrm(ks[16], (L, HEAD_V), 0.05),
        'w_out': nrm(ks[17], (L, D_MIX, D_MODEL), D_MIX ** -0.5),
        'norm2_g': 1.0 + nrm(ks[18], (L, D_MODEL), 0.05),
        'w_gate': nrm(ks[19], (L, D_MODEL, D_FF), D_MODEL ** -0.5),
        'w_up': nrm(ks[20], (L, D_MODEL, D_FF), D_MODEL ** -0.5),
        'w_down': nrm(ks[21], (L, D_FF, D_MODEL), D_FF ** -0.5),
        'rel_bias': nrm(ks[22], (REL_BUCKETS, N_HEADS), 0.5),
    }


def reference(x, norm1_g, w_in, pool_w, pool_scale, sconv_w, conf_dw_w, conf_dw_b, conf_ln_g,
              conf_ln_b, q_norm_g, k_norm_g, lam_q1, lam_k1, lam_q2, lam_k2, subln_g, w_out,
              norm2_g, w_gate, w_up, w_down, rel_bias):
    for l in range(DEPTH):
        lam_init = 0.8 - 0.6 * math.exp(-0.3 * l)
        x = hybrid_layer(x, norm1_g[l], w_in[l], pool_w[l], pool_scale[l], sconv_w[l],
                         conf_dw_w[l], conf_dw_b[l], conf_ln_g[l], conf_ln_b[l], q_norm_g[l],
                         k_norm_g[l], lam_q1[l], lam_k1[l], lam_q2[l], lam_k2[l], subln_g[l],
                         w_out[l], norm2_g[l], w_gate[l], w_up[l], w_down[l], rel_bias, lam_init)
    return x
```

```cpp
#include <hip/hip_runtime.h>
#include <cstdio>
#include <cstdint>
#define MK_PER_PHASE 1
namespace pg8 {
#define PG8_LAS __attribute__((address_space(3)))
typedef unsigned short bf16_t;
typedef short bf16x8 __attribute__((ext_vector_type(8)));
typedef float f32x4 __attribute__((ext_vector_type(4)));
typedef unsigned u32x4 __attribute__((ext_vector_type(4)));
constexpr int BM = 256, BK = 64, HALF = 128, HTB = HALF * BK * 2  , STAGE_BYTES = 8 * HTB, NXCD = 8, WGM = 8;

__host__ __device__ __forceinline__ int lds_byte(int r, int c) { const int st = (r >> 4) * 2 + (c >> 5), rr = r & 15, cc = c & 31, ob = rr * 64 + cc * 2; return st * 1024 + (ob ^ (((ob >> 9) & 1) << 5)); }
__host__ __device__ __forceinline__ void stage_rc(int b, int& R, int& C) { const int st = b / 1024, sb = b % 1024, swz = sb ^ (((sb >> 9) & 1) << 5); R = (st >> 1) * 16 + swz / 64; C = (st & 1) * 32 + (swz % 64) / 2; }
__host__ __device__ __forceinline__ int perm32(int rho) { const int n = rho >> 4, i = rho & 15; return 8 * (i >> 2) + 4 * n + (i & 3); }

struct Unit { int pm, pn; };
struct Gemm { const bf16_t* A; const bf16_t* Bt; int M, N, K; };

struct StaticOrder {
    int nM, nN, nwg, G, c;
    __host__ __device__ void init(int M, int N, int G_, int c_) { nM = M / BM; nN = N / BM; nwg = nM * nN; G = G_; c = c_; }
    __host__ __device__ bool next(int i, Unit& u) const {
        const long L = (long)i * G + c; if (L >= nwg) return false;
        int wgid = (int)L; { const int q = nwg / NXCD, r = nwg % NXCD, xcd = wgid % NXCD, off = wgid / NXCD; wgid = (xcd < r ? xcd * (q + 1) : r * (q + 1) + (xcd - r) * q) + off; }
        const int nig = WGM * nN, gid = wgid / nig, fm = gid * WGM, gsz = (nM - fm) < WGM ? (nM - fm) : WGM;
        u.pm = fm + ((wgid % nig) % gsz); u.pn = (wgid % nig) / gsz; return true;
    }
    __device__ __forceinline__ void a_ready(const Unit&) const {}
    __device__ __forceinline__ void done(const Unit&) const {}
};

__device__ __forceinline__ unsigned cvt_pk_bf16(float lo, float hi) { unsigned r; asm volatile("v_cvt_pk_bf16_f32 %0, %1, %2" : "=v"(r) : "v"(lo), "v"(hi)); return r; }
typedef float f32x2 __attribute__((ext_vector_type(2)));

__device__ __forceinline__ float row_rstd(const float* part, int row, int fq) {
    const f32x4 p = *(const f32x4*)(part + (size_t)row * 16 + 4 * fq);
    float s = (p[0] + p[1]) + (p[2] + p[3]);
    s += __shfl_xor(s, 16); s += __shfl_xor(s, 32);
    return rsqrtf(s * (1.0f / 1024.0f) + 1e-6f);
}
__device__ __forceinline__ float silu_f(float g) { return g * __builtin_amdgcn_rcpf(1.0f + __builtin_amdgcn_exp2f(-1.4426950408889634f * g)); }

struct EpiZ {
    static constexpr bool PERM = true, AFTER_DRAIN = false;
    bf16_t* Z; int ldc; const float* part;
    __device__ __forceinline__ void operator()(const f32x4 (&acc)[2][2][4][2], const Unit& u, int wr, int wc, int fr, int fq) const {
        const int row0 = u.pm * BM + wr * 64 + fr, col0 = u.pn * BM + wc * 32 + 8 * fq;
#pragma unroll
        for (int ai = 0; ai < 2; ++ai)
#pragma unroll
            for (int m = 0; m < 4; ++m) {
                const int row = row0 + ai * HALF + m * 16;
                const float rs = row_rstd(part, row, fq);
                bf16_t* rowp = Z + (size_t)row * ldc + col0;
#pragma unroll
                for (int bj = 0; bj < 2; ++bj) {
                    const f32x4 v0 = acc[ai][bj][m][0] * rs, v1 = acc[ai][bj][m][1] * rs;
                    u32x4 w; w.x = cvt_pk_bf16(v0[0], v0[1]); w.y = cvt_pk_bf16(v0[2], v0[3]); w.z = cvt_pk_bf16(v1[0], v1[1]); w.w = cvt_pk_bf16(v1[2], v1[3]);
                    *(u32x4*)(rowp + bj * HALF) = w;
                }
            }
    }
};
struct EpiGLU {
    static constexpr bool PERM = true, AFTER_DRAIN = false;
    bf16_t* O; int ldc; const float* part;
    __device__ __forceinline__ void operator()(const f32x4 (&acc)[2][2][4][2], const Unit& u, int wr, int wc, int fr, int fq) const {
        const int row0 = u.pm * BM + wr * 64 + fr, col0 = u.pn * HALF + wc * 32 + 8 * fq;
#pragma unroll
        for (int ai = 0; ai < 2; ++ai)
#pragma unroll
            for (int m = 0; m < 4; ++m) {
                const int row = row0 + ai * HALF + m * 16;
                const float rs = row_rstd(part, row, fq);
                const f32x4 g0 = acc[ai][0][m][0] * rs, g1 = acc[ai][0][m][1] * rs, u0 = acc[ai][1][m][0] * rs, u1 = acc[ai][1][m][1] * rs;
                float a[8];
#pragma unroll
                for (int i = 0; i < 4; ++i) { a[i] = silu_f(g0[i]) * u0[i]; a[4 + i] = silu_f(g1[i]) * u1[i]; }
                u32x4 w; w.x = cvt_pk_bf16(a[0], a[1]); w.y = cvt_pk_bf16(a[2], a[3]); w.z = cvt_pk_bf16(a[4], a[5]); w.w = cvt_pk_bf16(a[6], a[7]);
                *(u32x4*)(O + (size_t)row * ldc + col0) = w;
            }
    }
};
struct EpiRes {
    static constexpr bool PERM = true, AFTER_DRAIN = false;
    const float* base; float* out; bf16_t* xb; float* part;
    __device__ __forceinline__ void operator()(const f32x4 (&acc)[2][2][4][2], const Unit& u, int wr, int wc, int fr, int fq) const {
        const int row0 = u.pm * BM + wr * 64 + fr, col0 = u.pn * BM + wc * 32 + 8 * fq;
#pragma unroll
        for (int ai = 0; ai < 2; ++ai)
#pragma unroll
            for (int m = 0; m < 4; ++m) {
                const int row = row0 + ai * HALF + m * 16; const size_t off = (size_t)row * 1024 + col0;
                float ss = 0.f;
#pragma unroll
                for (int bj = 0; bj < 2; ++bj) {
                    const f32x4 b0 = *(const f32x4*)(base + off + bj * HALF), b1 = *(const f32x4*)(base + off + bj * HALF + 4);
                    const f32x4 o0 = b0 + acc[ai][bj][m][0], o1 = b1 + acc[ai][bj][m][1];
                    *(f32x4*)(out + off + bj * HALF) = o0; *(f32x4*)(out + off + bj * HALF + 4) = o1;
                    u32x4 w; w.x = cvt_pk_bf16(o0[0], o0[1]); w.y = cvt_pk_bf16(o0[2], o0[3]); w.z = cvt_pk_bf16(o1[0], o1[1]); w.w = cvt_pk_bf16(o1[2], o1[3]);
                    *(u32x4*)(xb + off + bj * HALF) = w;
                    ss += ((o0[0] * o0[0] + o0[1] * o0[1]) + (o0[2] * o0[2] + o0[3] * o0[3])) + ((o1[0] * o1[0] + o1[1] * o1[1]) + (o1[2] * o1[2] + o1[3] * o1[3]));
                }
                ss += __shfl_xor(ss, 16); ss += __shfl_xor(ss, 32);
                if (fq == 0) part[(size_t)row * 16 + u.pn * 4 + wc] = ss;
                if (m & 1) asm volatile("" ::: "memory");
            }
    }
};

template <class Epi, class Sched, bool ALIGN_EPI = false, bool SP2 = false>
__device__ __forceinline__ void gemm_phase(PG8_LAS unsigned char* lds, const Gemm g, const Sched& S, const Epi& E) {
    int tid_ = threadIdx.x; asm volatile("" : "+v"(tid_));
    const int tid = tid_, wid = __builtin_amdgcn_readfirstlane(tid >> 6), lane = tid & 63, wr = wid >> 2, wc = wid & 3, fr = lane & 15, fq = lane >> 4;
    const int K = g.K, nt = K / BK;
    unsigned voffA[2], voffB[2];
#pragma unroll
    for (int i = 0; i < 2; ++i) { int R, C; stage_rc(tid * 16 + i * 8192, R, C); const int Rb = Epi::PERM ? ((R & ~31) + perm32(R & 31)) : R;
        voffA[i] = (unsigned)(R * K + C) * 2u; voffB[i] = (unsigned)(Rb * K + C) * 2u; }
    const size_t kstep = (size_t)(BK * 2);
    const size_t hstep = (size_t)HALF * K * 2;
    const size_t tstep = 2 * hstep;
    const unsigned ldsw = (unsigned)wid * 1024u;
    const int aoff = lds_byte(wr * 64 + fr, fq * 8), boff = lds_byte(wc * 32 + fr, fq * 8);
#define PG8_SA(b, h) (((b) * 2 + (h)) * HTB)
#define PG8_SB(b, h) ((4 + (b) * 2 + (h)) * HTB)
#define PG8_STAGE(bufoff, gbase, voff) do { _Pragma("unroll") for (int _i = 0; _i < 2; ++_i) \
        __builtin_amdgcn_global_load_lds((const unsigned*)((const char*)(gbase) + (voff)[_i]), (PG8_LAS unsigned*)(lds + (bufoff) + ldsw + _i * 8192), 16, 0, 0); } while (0)
#define PG8_LDA(dst, b, h) do { _Pragma("unroll") for (int m = 0; m < 4; ++m) _Pragma("unroll") for (int k = 0; k < 2; ++k) dst[m][k] = *(const PG8_LAS bf16x8*)(lds + PG8_SA(b, h) + aoff + m * 2048 + k * 1024); } while (0)
#define PG8_LDB(dst, b, h) do { _Pragma("unroll") for (int n = 0; n < 2; ++n) _Pragma("unroll") for (int k = 0; k < 2; ++k) dst[n][k] = *(const PG8_LAS bf16x8*)(lds + PG8_SB(b, h) + boff + n * 2048 + k * 1024); } while (0)
#define PG8_MMA(ai, bj, At, Bt) do { __builtin_amdgcn_s_setprio(1); _Pragma("unroll") for (int m = 0; m < 4; ++m) _Pragma("unroll") for (int n = 0; n < 2; ++n) _Pragma("unroll") for (int k = 0; k < 2; ++k) \
        acc[ai][bj][m][n] = __builtin_amdgcn_mfma_f32_16x16x32_bf16(Bt[n][k], At[m][k], acc[ai][bj][m][n], 0, 0, 0); __builtin_amdgcn_s_setprio(0); } while (0)
#define PG8_WAIT_V(n) asm volatile("s_waitcnt vmcnt(" #n ")" ::: "memory")
#define PG8_WAIT_L(n) asm volatile("s_waitcnt lgkmcnt(" #n ")" ::: "memory")
#define PG8_BAR __builtin_amdgcn_s_barrier()
#define PG8_SCHED __builtin_amdgcn_sched_barrier(0)
    Unit cur, nxt; int ui = 0;
    if (!S.next(0, cur)) return;
    f32x4 acc[2][2][4][2];
#pragma unroll
    for (int a = 0; a < 2; ++a)
#pragma unroll
        for (int b = 0; b < 2; ++b)
#pragma unroll
            for (int m = 0; m < 4; ++m)
#pragma unroll
                for (int n = 0; n < 2; ++n) acc[a][b][m][n] = (f32x4){0.f, 0.f, 0.f, 0.f};
    bf16x8 At[4][2], B0[2][2], B1[2][2];
    const char* cA = (const char*)g.A + (size_t)cur.pm * tstep; const char* cB = (const char*)g.Bt + (size_t)cur.pn * tstep;
    S.a_ready(cur);
    if constexpr (SP2) {
        PG8_STAGE(PG8_SB(0, 0), cB, voffB); PG8_STAGE(PG8_SB(0, 1), cB + hstep, voffB); PG8_STAGE(PG8_SA(0, 0), cA, voffA); PG8_STAGE(PG8_SA(0, 1), cA + hstep, voffA);
        if (wr == 1) PG8_BAR;
        PG8_WAIT_V(2); PG8_BAR;
        PG8_STAGE(PG8_SB(1, 0), cB + kstep, voffB); PG8_STAGE(PG8_SA(1, 0), cA + kstep, voffA); PG8_STAGE(PG8_SB(1, 1), cB + hstep + kstep, voffB);
        PG8_WAIT_V(6); PG8_BAR;
    } else {
        PG8_STAGE(PG8_SB(0, 0), cB, voffB); PG8_STAGE(PG8_SA(0, 0), cA, voffA); PG8_STAGE(PG8_SB(0, 1), cB + hstep, voffB); PG8_STAGE(PG8_SA(0, 1), cA + hstep, voffA);
        if (wr == 1) PG8_BAR;
        PG8_WAIT_V(4); PG8_BAR;
        PG8_STAGE(PG8_SB(1, 0), cB + kstep, voffB); PG8_STAGE(PG8_SA(1, 0), cA + kstep, voffA); PG8_STAGE(PG8_SB(1, 1), cB + hstep + kstep, voffB);
        PG8_WAIT_V(6); PG8_BAR;
    }
    for (;;) {
        const bool has_next = S.next(ui + 1, nxt);
        const char* nA = has_next ? (const char*)g.A + (size_t)nxt.pm * tstep : cA; const char* nB = has_next ? (const char*)g.Bt + (size_t)nxt.pn * tstep : cB;
        for (int t = 0; t < nt; t += 2) {
            const bool last = (t == nt - 2);
            const char* a1 = cA + (size_t)(t + 1) * kstep;
            const char* a2 = last ? nA : cA + (size_t)(t + 2) * kstep; const char* b2 = last ? nB : cB + (size_t)(t + 2) * kstep;
            const char* a3 = a2 + kstep; const char* b3 = b2 + kstep;
            if (last && has_next) S.a_ready(nxt);
            if constexpr (SP2) {
            PG8_LDB(B0, 0, 0); PG8_LDB(B1, 0, 1); PG8_SCHED; PG8_LDA(At, 0, 0); PG8_STAGE(PG8_SA(1, 1), a1 + hstep, voffA);
            PG8_WAIT_V(8); PG8_WAIT_L(0); PG8_BAR; PG8_MMA(0, 0, At, B0); PG8_MMA(0, 1, At, B1); PG8_BAR; PG8_SCHED;
            PG8_LDA(At, 0, 1); PG8_STAGE(PG8_SB(0, 0), b2, voffB); PG8_STAGE(PG8_SB(0, 1), b2 + hstep, voffB); PG8_STAGE(PG8_SA(0, 0), a2, voffA);
            PG8_WAIT_V(8); PG8_WAIT_L(0); PG8_BAR; PG8_MMA(1, 0, At, B0); PG8_MMA(1, 1, At, B1); PG8_BAR; PG8_SCHED;
            PG8_LDB(B0, 1, 0); PG8_LDB(B1, 1, 1); PG8_SCHED; PG8_LDA(At, 1, 0); PG8_STAGE(PG8_SA(0, 1), a2 + hstep, voffA);
            PG8_WAIT_V(8); PG8_WAIT_L(0); PG8_BAR; PG8_MMA(0, 0, At, B0); PG8_MMA(0, 1, At, B1); PG8_BAR; PG8_SCHED;
            PG8_LDA(At, 1, 1); PG8_STAGE(PG8_SB(1, 0), b3, voffB); PG8_STAGE(PG8_SB(1, 1), b3 + hstep, voffB); PG8_STAGE(PG8_SA(1, 0), a3, voffA);
            PG8_WAIT_V(8); PG8_WAIT_L(0); PG8_BAR; PG8_MMA(1, 0, At, B0); PG8_MMA(1, 1, At, B1); PG8_BAR; PG8_SCHED;
            } else {
            PG8_LDB(B0, 0, 0); PG8_SCHED; PG8_LDA(At, 0, 0); PG8_STAGE(PG8_SA(1, 1), a1 + hstep, voffA);
            PG8_WAIT_L(8); PG8_BAR; PG8_WAIT_L(0); PG8_MMA(0, 0, At, B0); PG8_BAR; PG8_SCHED;
            PG8_LDB(B1, 0, 1); PG8_STAGE(PG8_SB(0, 0), b2, voffB);
            PG8_BAR; PG8_WAIT_L(0); PG8_MMA(0, 1, At, B1); PG8_BAR;
            PG8_LDA(At, 0, 1); PG8_STAGE(PG8_SA(0, 0), a2, voffA);
            PG8_BAR; PG8_WAIT_L(0); PG8_MMA(1, 0, At, B0); PG8_BAR; PG8_SCHED;
            PG8_STAGE(PG8_SB(0, 1), b2 + hstep, voffB);
            PG8_WAIT_V(6); PG8_BAR; PG8_MMA(1, 1, At, B1); PG8_BAR;
            PG8_LDB(B0, 1, 0); PG8_SCHED; PG8_LDA(At, 1, 0); PG8_STAGE(PG8_SA(0, 1), a2 + hstep, voffA);
            PG8_WAIT_L(8); PG8_BAR; PG8_WAIT_L(0); PG8_MMA(0, 0, At, B0); PG8_BAR; PG8_SCHED;
            PG8_LDB(B1, 1, 1); PG8_STAGE(PG8_SB(1, 0), b3, voffB);
            PG8_BAR; PG8_WAIT_L(0); PG8_MMA(0, 1, At, B1); PG8_BAR;
            PG8_LDA(At, 1, 1); PG8_STAGE(PG8_SA(1, 0), a3, voffA);
            PG8_BAR; PG8_WAIT_L(0); PG8_MMA(1, 0, At, B0); PG8_BAR; PG8_SCHED;
            PG8_STAGE(PG8_SB(1, 1), b3 + hstep, voffB);
            PG8_WAIT_V(6); PG8_BAR; PG8_MMA(1, 1, At, B1); PG8_BAR;
            }
        }
        if constexpr (ALIGN_EPI) { if (wr == 0) PG8_BAR; }
        if constexpr (!Epi::AFTER_DRAIN) { E(acc, cur, wr, wc, fr, fq); S.done(cur); }
        if (!has_next) break;
#pragma unroll
        for (int a = 0; a < 2; ++a)
#pragma unroll
            for (int b = 0; b < 2; ++b)
#pragma unroll
                for (int m = 0; m < 4; ++m)
#pragma unroll
                    for (int n = 0; n < 2; ++n) acc[a][b][m][n] = (f32x4){0.f, 0.f, 0.f, 0.f};
        cur = nxt; cA = nA; cB = nB; ++ui;
        if constexpr (ALIGN_EPI) { if (wr == 1) PG8_BAR; }
    }
    PG8_WAIT_V(0);
    if constexpr (!ALIGN_EPI) { if (wr == 0) PG8_BAR; }
    PG8_BAR;
    if constexpr (Epi::AFTER_DRAIN) { E.fused(acc, cur, wr, wc, fr, fq, lds, wid, lane); S.done(cur); }
#undef PG8_SA
#undef PG8_SB
#undef PG8_STAGE
#undef PG8_LDA
#undef PG8_LDB
#undef PG8_MMA
#undef PG8_WAIT_V
#undef PG8_WAIT_L
#undef PG8_BAR
#undef PG8_SCHED
}
}
#define GAS __attribute__((address_space(1)))
#define LAS __attribute__((address_space(3)))
typedef unsigned short bf16;
typedef unsigned v4u __attribute__((ext_vector_type(4)));
typedef float f32x4 __attribute__((ext_vector_type(4)));
typedef short bf16x8 __attribute__((ext_vector_type(8)));
typedef GAS unsigned gu32;
typedef GAS unsigned long long gu64;
#define RLX_AGENT __ATOMIC_RELAXED, __HIP_MEMORY_SCOPE_AGENT
#define LDS_WAIT() asm volatile("s_waitcnt lgkmcnt(0)" ::: "memory")
#define VM_WAIT() asm volatile("s_waitcnt vmcnt(0)" ::: "memory")
__device__ __forceinline__ unsigned long long rt() { return __builtin_amdgcn_s_memrealtime(); }
__device__ __forceinline__ unsigned f2bf(float f) { unsigned u = __builtin_bit_cast(unsigned, f); return (u + 0x7fffu + ((u >> 16) & 1u)) >> 16; }
__device__ __forceinline__ unsigned pk2(float lo, float hi) { return f2bf(lo) | (f2bf(hi) << 16); }

#define XB_TMO      128
#define XB_XCNT(j)  (256  + 64 * (j))
#define XB_XSUB(j)  (1280 + 64 * (j))
#define XB_XGEN(j)  (2304 + 64 * (j))
#define XB_TOP      3328
#define XB_TOPGEN   3392
#define XCD_BAR_WORDS 3456
#define XB_SPIN_CAP (1u << 18)

__device__ __forceinline__ unsigned xb_ld(unsigned* p)              { return __hip_atomic_load(p, __ATOMIC_RELAXED, __HIP_MEMORY_SCOPE_AGENT); }
__device__ __forceinline__ unsigned xb_add(unsigned* p, unsigned v) { return __hip_atomic_fetch_add(p, v, __ATOMIC_RELAXED, __HIP_MEMORY_SCOPE_AGENT); }
__device__ __forceinline__ unsigned xb_xcc_id() { return (unsigned)__builtin_amdgcn_s_getreg((3 << 11) | 20) & 0xFu; }
#define XB_SPIN(cond, bar) do { unsigned _sp = 0; while (cond) { __builtin_amdgcn_s_sleep(1); \
    if ((++_sp & 255u) == 0u) { if (xb_ld(&(bar)[XB_TMO])) break; if (_sp > XB_SPIN_CAP) { atomicAdd(&(bar)[XB_TMO], 1u); break; } } } } while (0)

struct XcdBarrier {
    unsigned* bar; unsigned x;
    volatile LAS unsigned* st;
};

__device__ __forceinline__ XcdBarrier xcd_barrier_post(unsigned* bar, volatile LAS unsigned* st) {
    XcdBarrier b; b.bar = bar; b.x = xb_xcc_id(); b.st = st;
    if (threadIdx.x == 0) (void)xb_add(&bar[XB_XCNT(b.x)], 1u);
    return b;
}
__device__ __forceinline__ void xcd_barrier_complete(unsigned* bar, unsigned x, unsigned& nloc, unsigned& nx) {
    const unsigned G = gridDim.x * gridDim.y * gridDim.z;
    unsigned sum, cnt, mine, sp = 0u;
    for (;;) {
        sum = 0u; cnt = 0u; mine = 0u;
#pragma unroll
        for (unsigned j = 0; j < 16; ++j) { const unsigned c = xb_ld(&bar[XB_XCNT(j)]); sum += c; cnt += (c > 0u) ? 1u : 0u; mine = (j == x) ? c : mine; }
        if (sum == G) break;
        __builtin_amdgcn_s_sleep(1);
        if ((++sp & 255u) == 0u) { if (xb_ld(&bar[XB_TMO])) break; if (sp > XB_SPIN_CAP) { atomicAdd(&bar[XB_TMO], 1u); break; } }
    }
    nloc = mine > 0u ? mine : 1u; nx = cnt > 0u ? cnt : 1u;
}

__device__ __forceinline__ void xcd_barrier(const XcdBarrier& b) {
    asm volatile("s_waitcnt vmcnt(0)" ::: "memory");
    __syncthreads();
    if (threadIdx.x == 0) {
        unsigned* bar = b.bar;
        __builtin_amdgcn_s_waitcnt(0);
        unsigned nloc = b.st[0], nx = b.st[1];
        if (nloc == 0u) { xcd_barrier_complete(bar, b.x, nloc, nx); b.st[0] = nloc; b.st[1] = nx; }
        const unsigned old = xb_add(&bar[XB_XSUB(b.x)], 1u);
        const unsigned gen = old / nloc;
        if (old + 1u == (gen + 1u) * nloc) {
            __builtin_amdgcn_fence(__ATOMIC_RELEASE, "agent");
            asm volatile("s_waitcnt vmcnt(0)" ::: "memory");
            const unsigned og = xb_add(&bar[XB_TOP], 1u);
            const unsigned tg = og / nx;
            if (og + 1u == (tg + 1u) * nx) xb_add(&bar[XB_TOPGEN], 1u);
            else XB_SPIN(xb_ld(&bar[XB_TOPGEN]) == tg, bar);
            __builtin_amdgcn_fence(__ATOMIC_ACQUIRE, "agent");
            xb_add(&bar[XB_XGEN(b.x)], 1u);
            asm volatile("s_waitcnt vmcnt(0)" ::: "memory");
        } else {
            XB_SPIN(xb_ld(&bar[XB_XGEN(b.x)]) == gen, bar);
            __builtin_amdgcn_fence(__ATOMIC_ACQUIRE, "agent");
            asm volatile("s_waitcnt vmcnt(0)" ::: "memory");
        }
    }
    __syncthreads();
}
#ifndef PG8_SP2
#define PG8_SP2 true
#endif
#ifndef PG8_ALIGN
#define PG8_ALIGN true
#endif
#ifndef MK_PER_PHASE
#define MK_PER_PHASE 0
#endif
constexpr int NWAVES = 8;
constexpr int BATCH = 16, SEQ = 2048, D = 1024, DEPTH = 2, M = BATCH * SEQ;
constexpr int DIN = 2304, DFF = 2816, NGU = 2 * DFF;
constexpr int NH = 4;
constexpr float EPS = 1e-6f;
constexpr int NPH = 1 + 5 * DEPTH;
enum { I_X = 0, I_N1G, I_WIN, I_POOLW, I_POOLS, I_SCONVW, I_CDWW, I_CDWB, I_CLNG, I_CLNB, I_QNG, I_KNG, I_LQ1, I_LK1, I_LQ2, I_LK2, I_SUBG, I_WOUT, I_N2G, I_WGATE, I_WUP, I_WDOWN, I_RELB, N_IN };
constexpr size_t MiB = 1u << 20;
constexpr size_t WS_CTL = 0, CTL_ZERO_BYTES = 1 * MiB;
constexpr size_t WS_PART = 1 * MiB;
constexpr size_t WS_W = 4 * MiB, W_LAYER = 23 * MiB;
constexpr size_t WOFF_IN = 0, WOFF_OUT = (size_t)DIN * D * 2, WOFF_GU = WOFF_OUT + (size_t)D * D * 2, WOFF_DN = WOFF_GU + (size_t)NGU * D * 2;
static_assert(WOFF_DN + (size_t)D * DFF * 2 <= W_LAYER, "weight map");
constexpr size_t WS_XB = WS_W + DEPTH * W_LAYER;
constexpr size_t WS_Z = WS_XB + (size_t)M * D * 2;
constexpr size_t WS_MIX = WS_Z + (size_t)M * DIN * 2;
constexpr size_t WS_ACT = WS_Z;
constexpr size_t WS_END = WS_MIX + (size_t)M * D * 2;
static_assert(WS_ACT + (size_t)M * DFF * 2 <= WS_END, "ACT overlay");
constexpr int CW_TMO = 0, CW_CODE = 1;
constexpr int CW_BAR = 4096;
constexpr int RING_OFF = 0, RING_BYTES = 131072;
constexpr int LDSCTL_OFF = RING_BYTES, MISC_OFF = LDSCTL_OFF + 320;
constexpr int AUX_OFF = RING_BYTES + 1024;
constexpr int LDS_BYTES = 147456;
static_assert(AUX_OFF + 8192 <= LDS_BYTES, "LDS map");


struct Args { const float* in[N_IN]; float* out; unsigned char* ws; int ph_lo, ph_hi; };
static_assert(sizeof(Args) == N_IN * 8 + 8 + 8 + 8, "Args has no padding");
struct Frame {
    LAS unsigned char* lds;
    volatile LAS unsigned* MISC;
    gu32* ctl;
    int tid, lane, wave;
    int vcu, G;
    float* out; unsigned char* ws;
    bf16 *XB, *Z, *MIX, *ACT; float* part;
};
__device__ __forceinline__ bf16* w_ptr(const Frame& F, int l, size_t off) { return (bf16*)(F.ws + WS_W + (size_t)l * W_LAYER + off); }
__device__ __forceinline__ float bf2f(bf16 v) { return __uint_as_float((unsigned)v << 16); }
__device__ __forceinline__ float wave_sum(float v) {
#pragma unroll
    for (int o = 1; o < 64; o <<= 1) v += __shfl_xor(v, o);
    return v;
}
__device__ __forceinline__ float wave_max(float v) {
#pragma unroll
    for (int o = 1; o < 64; o <<= 1) v = fmaxf(v, __shfl_xor(v, o));
    return v;
}
__device__ const unsigned char REL_BUCKET_TAB[128] = {
    0, 1, 2, 3, 4, 5, 6, 7, 8, 9, 10, 11, 12, 13, 14, 15, 16, 16, 16, 17, 17, 18, 18, 18, 19, 19, 19, 20, 20, 20, 20, 21, 21, 21, 21, 22, 22, 22, 22, 22, 23, 23, 23, 23, 23, 23, 24, 24, 24, 24, 24, 24,
    25, 25, 25, 25, 25, 25, 25, 26, 26, 26, 26, 26, 26, 26, 26, 27, 27, 27, 27, 27, 27, 27, 27, 27, 27, 28, 28, 28, 28, 28, 28, 28, 28, 28, 28, 29, 29, 29, 29, 29, 29, 29, 29, 29, 29, 29, 29,
    30, 30, 30, 30, 30, 30, 30, 30, 30, 30, 30, 30, 30, 30, 31, 31, 31, 31, 31, 31, 31, 31, 31, 31, 31, 31, 31, 31, 31};

__device__ __forceinline__ void p0_transpose_item(const float* W, int K, int N, const float* gain, bf16* WT, int dst_row0, int k0, int n0, LAS float* scr, int lane) {
#pragma unroll 8
    for (int i = 0; i < 32; ++i) { const int kk = 2 * i + (lane >> 5); float v = W[(size_t)(k0 + kk) * N + n0 + (lane & 31)]; if (gain) v *= gain[k0 + kk]; scr[kk * 33 + (lane & 31)] = v; }
    LDS_WAIT(); asm volatile("" ::: "memory");
    const int c = lane & 7;
#pragma unroll
    for (int j = 0; j < 4; ++j) { const int n = (lane >> 3) + 8 * j; const LAS float* s = scr + (8 * c) * 33 + n;
        v4u o; o.x = pk2(s[0 * 33], s[1 * 33]); o.y = pk2(s[2 * 33], s[3 * 33]); o.z = pk2(s[4 * 33], s[5 * 33]); o.w = pk2(s[6 * 33], s[7 * 33]);
        *(GAS v4u*)(WT + (size_t)(dst_row0 + n) * K + k0 + 8 * c) = o; }
    LDS_WAIT(); asm volatile("" ::: "memory");
}
__device__ __forceinline__ void p0_prologue(Frame& F, const Args& A) {
    int tid_ = threadIdx.x; asm volatile("" : "+v"(tid_));
    const int lane = tid_ & 63, wave = __builtin_amdgcn_readfirstlane(tid_ >> 6);
    LAS float* scr = (LAS float*)(F.lds + RING_OFF + wave * 16384);
    const int gw = F.vcu * NWAVES + wave, NGW = F.G * NWAVES;
    constexpr int I_IN = (D / 64) * (DIN / 32), I_OUT = (D / 64) * (D / 32), I_G = (D / 64) * (DFF / 32), I_DN = (DFF / 64) * (D / 32);
    constexpr int PER_L = I_IN + I_OUT + 2 * I_G + I_DN;
    for (int it = gw; it < DEPTH * PER_L; it += NGW) {
        const int l = it / PER_L; int r = it % PER_L;
        if (r < I_IN) { const int nb = DIN / 32, kb = r / nb, n0 = 32 * (r % nb);
            p0_transpose_item(A.in[I_WIN] + (size_t)l * D * DIN, D, DIN, A.in[I_N1G] + l * D, w_ptr(F, l, WOFF_IN), n0, 64 * kb, n0, scr, lane); continue; } r -= I_IN;
        if (r < I_OUT) { const int nb = D / 32, kb = r / nb, n0 = 32 * (r % nb);
            p0_transpose_item(A.in[I_WOUT] + (size_t)l * D * D, D, D, nullptr, w_ptr(F, l, WOFF_OUT), n0, 64 * kb, n0, scr, lane); continue; } r -= I_OUT;
        if (r < 2 * I_G) { const int up = r >= I_G; if (up) r -= I_G; const int nb = DFF / 32, kb = r / nb, n0 = 32 * (r % nb);
            const int dst = 256 * (n0 / 128) + 128 * up + (n0 % 128);
            p0_transpose_item(A.in[up ? I_WUP : I_WGATE] + (size_t)l * D * DFF, D, DFF, A.in[I_N2G] + l * D, w_ptr(F, l, WOFF_GU), dst, 64 * kb, n0, scr, lane); continue; } r -= 2 * I_G;
        { const int nb = D / 32, kb = r / nb, n0 = 32 * (r % nb);
            p0_transpose_item(A.in[I_WDOWN] + (size_t)l * DFF * D, DFF, D, nullptr, w_ptr(F, l, WOFF_DN), n0, 64 * kb, n0, scr, lane); }
    }
    const float* x = A.in[I_X];
    for (int m = gw; m < M; m += NGW) {
        const GAS f32x4* xr = (const GAS f32x4*)(x + (size_t)m * D) + lane;
        f32x4 v[4]; float s = 0.f;
#pragma unroll
        for (int j = 0; j < 4; ++j) { v[j] = xr[64 * j]; s += (v[j].x * v[j].x + v[j].y * v[j].y) + (v[j].z * v[j].z + v[j].w * v[j].w); }
        s = wave_sum(s);
        GAS unsigned long long* o8 = (GAS unsigned long long*)(F.XB + (size_t)m * D) + lane;
#pragma unroll
        for (int j = 0; j < 4; ++j) o8[64 * j] = (unsigned long long)pk2(v[j].x, v[j].y) | ((unsigned long long)pk2(v[j].z, v[j].w) << 32);
        if (lane < 16) F.part[(size_t)m * 16 + lane] = (lane == 0) ? s : 0.f;
    }
}

__device__ __forceinline__ void p2_simple(Frame& F, const Args& A, int l) {
    const float* pool_w = A.in[I_POOLW] + (size_t)l * 4 * 64 * 64; const float* pool_s = A.in[I_POOLS] + l * 256; const float* sconv_w = A.in[I_SCONVW] + l * 3 * 256;
    const float* cdw_w = A.in[I_CDWW] + l * 31 * 256; const float* cdw_b = A.in[I_CDWB] + l * 256; const float* cln_g = A.in[I_CLNG] + l * 256; const float* cln_b = A.in[I_CLNB] + l * 256;
    const float* qng = A.in[I_QNG] + l * 32; const float* kng = A.in[I_KNG] + l * 32; const float* subg = A.in[I_SUBG] + l * 64; const float* relb = A.in[I_RELB];
    const bf16* Z = F.Z; bf16* MIX = F.MIX;
    int tid_ = threadIdx.x; asm volatile("" : "+v"(tid_));
    const int tid = tid_, lane = tid & 63, wave = __builtin_amdgcn_readfirstlane(tid >> 6), c = tid & 255, hf = tid >> 8;
    LAS float* bufA = (LAS float*)(F.lds + RING_OFF);
    LAS float* bufC = bufA + 32 * 256;
    LAS float* bufU = bufC + 32 * 256;
    for (int u = F.vcu; u < M / 32; u += F.G) {
        const int row0 = u * 32, pos0 = row0 & (SEQ - 1);
#pragma nounroll
        for (int j = hf * 31; j < hf * 31 + 31; ++j) {
            const int pos = pos0 - 30 + j; float uv = 0.f;
            if (pos >= 0) { const size_t r = (size_t)(row0 - 30 + j) * DIN; const float a = bf2f(Z[r + 1024 + c]), g = bf2f(Z[r + 1280 + c]); uv = a / (1.0f + __expf(-g)); }
            bufU[j * 256 + c] = uv;
        }
        const int g4 = c >> 6, win = 2 << g4;
#pragma nounroll
        for (int i = hf * 16; i < hf * 16 + 16; ++i) {
            const int row = row0 + i, pos = pos0 + i; const int cnt = (pos + 1) < win ? (pos + 1) : win;
            float s = 0.f;
#pragma nounroll
            for (int j = 0; j < cnt; ++j) s += bf2f(Z[(size_t)(row - j) * DIN + c]);
            bufA[i * 256 + c] = s / (float)cnt - bf2f(Z[(size_t)row * DIN + c]);
            float a = 0.f;
#pragma unroll
            for (int j = 0; j < 3; ++j) { const int pp = pos - 2 + j; if (pp >= 0) { const size_t r = (size_t)(row - 2 + j) * DIN; a += sconv_w[j * 256 + c] * (bf2f(Z[r + 512 + c]) * bf2f(Z[r + 768 + c])); } }
            MIX[(size_t)row * D + 256 + c] = (bf16)f2bf(bf2f(Z[(size_t)row * DIN + 256 + c]) * a);
        }
        __syncthreads();
#pragma nounroll
        for (int i = hf * 16; i < hf * 16 + 16; ++i) {
            float a = cdw_b[c];
#pragma unroll 4
            for (int j = 0; j < 31; ++j) a += cdw_w[j * 256 + c] * bufU[(i + j) * 256 + c];
            bufC[i * 256 + c] = a;
        }
        { const int dd = c & 63; float acc[16];
#pragma unroll
            for (int i = 0; i < 16; ++i) acc[i] = 0.f;
#pragma unroll 2
            for (int cc = 0; cc < 64; ++cc) { const float w = pool_w[(g4 * 64 + cc) * 64 + dd];
#pragma unroll
                for (int i = 0; i < 16; ++i) acc[i] += bufA[(hf * 16 + i) * 256 + g4 * 64 + cc] * w; }
            const float ps = pool_s[c];
#pragma unroll
            for (int i = 0; i < 16; ++i) MIX[(size_t)(row0 + hf * 16 + i) * D + c] = (bf16)f2bf(acc[i] * ps); }
        __syncthreads();
#pragma nounroll
        for (int k = 0; k < 4; ++k) { const int i = wave + 8 * k;
            const f32x4 v = *(const LAS f32x4*)(bufC + i * 256 + lane * 4);
            const float mean = wave_sum((v.x + v.y) + (v.z + v.w)) * (1.0f / 256.0f);
            const f32x4 xc = v - mean;
            const float var = wave_sum((xc.x * xc.x + xc.y * xc.y) + (xc.z * xc.z + xc.w * xc.w)) * (1.0f / 256.0f);
            const float r = rsqrtf(var + EPS);
            const f32x4 gg = *(const f32x4*)(cln_g + lane * 4), bb = *(const f32x4*)(cln_b + lane * 4);
            float y[4];
#pragma unroll
            for (int e = 0; e < 4; ++e) { const float t = xc[e] * r * gg[e] + bb[e]; y[e] = t / (1.0f + __expf(-t)); }
            *(unsigned long long*)(MIX + (size_t)(row0 + i) * D + 512 + lane * 4) = (unsigned long long)pk2(y[0], y[1]) | ((unsigned long long)pk2(y[2], y[3]) << 32);
        }
        __syncthreads();
    }
    LAS float* tab = (LAS float*)(F.lds + AUX_OFF);
    LAS float* qs = tab + 512 + wave * 64;
    for (int i = tid; i < 512; i += NWAVES * 64) tab[i] = relb[(int)REL_BUCKET_TAB[i & 127] * NH + (i >> 7)];
    float lam, lam_init;
    { float s1 = 0.f, s2 = 0.f;
      for (int i = 0; i < 32; ++i) { s1 += A.in[I_LQ1][l * 32 + i] * A.in[I_LK1][l * 32 + i]; s2 += A.in[I_LQ2][l * 32 + i] * A.in[I_LK2][l * 32 + i]; }
      lam_init = 0.8f - 0.6f * expf(-0.3f * (float)l); lam = expf(s1) - expf(s2) + lam_init; }
    __syncthreads();
    LAS float* sc0 = (LAS float*)(F.lds + RING_OFF) + wave * 4096; LAS float* sc1 = sc0 + 2048;
    const int gw = F.vcu * NWAVES + wave, NGW = F.G * NWAVES;
    for (int unit = gw; unit < BATCH * NH * SEQ; unit += NGW) {
        const int bh = unit & 63, q = unit >> 6, b = bh >> 2, h = bh & 3; const size_t row = (size_t)b * SEQ + q;
        { const float qv = bf2f(Z[row * DIN + 1536 + h * 64 + lane]); float ss = qv * qv;
#pragma unroll
          for (int o = 1; o < 32; o <<= 1) ss += __shfl_xor(ss, o);
          qs[lane] = qv * rsqrtf(ss * (1.0f / 32.0f) + EPS) * qng[lane & 31] * 0.17677669529663687f * kng[lane & 31]; }
        LDS_WAIT();
        float mx0 = -3.0e38f, mx1 = -3.0e38f;
#pragma nounroll
        for (int k = lane; k <= q; k += 64) {
            const bf16* kp = Z + ((size_t)b * SEQ + k) * DIN + 1792 + h * 64;
            float d0 = 0.f, d1 = 0.f, s0 = 0.f, s1 = 0.f;
#pragma unroll
            for (int e8 = 0; e8 < 4; ++e8) { const v4u w = *(const v4u*)(kp + 8 * e8);
#pragma unroll
                for (int e = 0; e < 4; ++e) { const float lo = __uint_as_float(w[e] << 16), hi = __uint_as_float(w[e] & 0xffff0000u); s0 += lo * lo + hi * hi; d0 += lo * qs[8 * e8 + 2 * e] + hi * qs[8 * e8 + 2 * e + 1]; } }
#pragma unroll
            for (int e8 = 0; e8 < 4; ++e8) { const v4u w = *(const v4u*)(kp + 32 + 8 * e8);
#pragma unroll
                for (int e = 0; e < 4; ++e) { const float lo = __uint_as_float(w[e] << 16), hi = __uint_as_float(w[e] & 0xffff0000u); s1 += lo * lo + hi * hi; d1 += lo * qs[32 + 8 * e8 + 2 * e] + hi * qs[32 + 8 * e8 + 2 * e + 1]; } }
            const int dist = q - k; const float bias = tab[h * 128 + (dist < 127 ? dist : 127)];
            const float a0 = d0 * rsqrtf(s0 * (1.0f / 32.0f) + EPS) + bias, a1 = d1 * rsqrtf(s1 * (1.0f / 32.0f) + EPS) + bias;
            sc0[k] = a0; sc1[k] = a1; mx0 = fmaxf(mx0, a0); mx1 = fmaxf(mx1, a1);
        }
        mx0 = wave_max(mx0); mx1 = wave_max(mx1);
        float l0 = 0.f, l1 = 0.f;
        for (int k = lane; k <= q; k += 64) { const float e0 = __expf(sc0[k] - mx0), e1 = __expf(sc1[k] - mx1); sc0[k] = e0; sc1[k] = e1; l0 += e0; l1 += e1; }
        l0 = wave_sum(l0); l1 = wave_sum(l1);
        const float c0 = 1.0f / l0, c1 = lam / l1;
        for (int k = lane; k <= q; k += 64) sc0[k] = sc0[k] * c0 - sc1[k] * c1;
        LDS_WAIT();
        float o = 0.f;
        const bf16* vp = Z + (size_t)b * SEQ * DIN + 2048 + h * 64 + lane;
#pragma unroll 4
        for (int k = 0; k <= q; ++k) o += sc0[k] * bf2f(vp[(size_t)k * DIN]);
        const float ss = wave_sum(o * o) * (1.0f / 64.0f);
        MIX[row * D + 768 + h * 64 + lane] = (bf16)f2bf(o * rsqrtf(ss + EPS) * subg[lane] * (1.0f - lam_init));
        LDS_WAIT();
    }
    __syncthreads();
}

__global__ void __launch_bounds__(NWAVES * 64, 2) fwd_kernel(Args args) {
    extern __shared__ __attribute__((aligned(16))) unsigned char lds[];
    Frame F;
    F.lds = (LAS unsigned char*)lds;
    F.MISC = (volatile LAS unsigned*)(F.lds + MISC_OFF);
    F.tid = threadIdx.x; F.lane = F.tid & 63; F.wave = __builtin_amdgcn_readfirstlane(F.tid >> 6);
    F.G = gridDim.x; { const int bx = blockIdx.x; F.vcu = (F.G % 8 == 0) ? (bx % 8) * (F.G / 8) + bx / 8 : bx; }
    unsigned char* ws = args.ws; F.ws = ws;
    F.ctl = (gu32*)(ws + WS_CTL);
    F.out = args.out;
    F.XB = (bf16*)(ws + WS_XB); F.Z = (bf16*)(ws + WS_Z); F.MIX = (bf16*)(ws + WS_MIX); F.ACT = (bf16*)(ws + WS_ACT); F.part = (float*)(ws + WS_PART);
    for (int u = F.tid; u < (LDS_BYTES - LDSCTL_OFF) / 4; u += NWAVES * 64) ((LAS unsigned*)(F.lds + LDSCTL_OFF))[u] = 0u;
    __syncthreads();
    XcdBarrier bar; bar.bar = (unsigned*)(F.ctl + CW_BAR); bar.x = 0; bar.st = nullptr;
    if (!MK_PER_PHASE) bar = xcd_barrier_post((unsigned*)(F.ctl + CW_BAR), F.MISC + 8);
    const int lo = args.ph_lo, hi = args.ph_hi;
#define IN(k) (lo <= (k) && (k) < hi)
#define BOTH(k) (IN(k) && IN((k) + 1))
#define GRID_BAR() do { if (MK_PER_PHASE) { if (F.tid == 0) __hip_atomic_store(F.ctl + CW_TMO, 0xBADBA0u, RLX_AGENT); } else { xcd_barrier(bar); } } while (0)

#ifndef NO_P0
    if (IN(0)) { p0_prologue(F, args); if (BOTH(0)) GRID_BAR(); }
#endif
    for (int l = 0; l < DEPTH; ++l) {
        const int p = 1 + 5 * l;
#ifndef NO_G1
        if (IN(p)) {
            pg8::Gemm g{F.XB, w_ptr(F, l, WOFF_IN), M, DIN, D}; pg8::StaticOrder S; S.init(M, DIN, F.G, (int)blockIdx.x);
            pg8::EpiZ E{F.Z, DIN, F.part};
            pg8::gemm_phase<pg8::EpiZ, pg8::StaticOrder, PG8_ALIGN, PG8_SP2>(F.lds + RING_OFF, g, S, E);
            if (BOTH(p)) GRID_BAR();
        }
#endif
        if (IN(p + 1)) {
#ifndef NO_P2
            p2_simple(F, args, l);
#endif
            if (BOTH(p + 1)) GRID_BAR();
        }
#ifndef NO_G3
        if (IN(p + 2)) {
            pg8::Gemm g{F.MIX, w_ptr(F, l, WOFF_OUT), M, D, D}; pg8::StaticOrder S; S.init(M, D, F.G, (int)blockIdx.x);
            pg8::EpiRes E{l == 0 ? args.in[I_X] : F.out, F.out, F.XB, F.part};
            pg8::gemm_phase<pg8::EpiRes, pg8::StaticOrder, PG8_ALIGN, PG8_SP2>(F.lds + RING_OFF, g, S, E);
            if (BOTH(p + 2)) GRID_BAR();
        }
#endif
#ifndef NO_G4
        if (IN(p + 3)) {
            pg8::Gemm g{F.XB, w_ptr(F, l, WOFF_GU), M, NGU, D}; pg8::StaticOrder S; S.init(M, NGU, F.G, (int)blockIdx.x);
            pg8::EpiGLU E{F.ACT, DFF, F.part};
            pg8::gemm_phase<pg8::EpiGLU, pg8::StaticOrder, PG8_ALIGN, PG8_SP2>(F.lds + RING_OFF, g, S, E);
            if (BOTH(p + 3)) GRID_BAR();
        }
#endif
#ifndef NO_G5
        if (IN(p + 4)) {
            pg8::Gemm g{F.ACT, w_ptr(F, l, WOFF_DN), M, D, DFF}; pg8::StaticOrder S; S.init(M, D, F.G, (int)blockIdx.x);
            pg8::EpiRes E{F.out, F.out, F.XB, F.part};
            pg8::gemm_phase<pg8::EpiRes, pg8::StaticOrder, PG8_ALIGN, PG8_SP2>(F.lds + RING_OFF, g, S, E);
            if (BOTH(p + 4)) GRID_BAR();
        }
#endif
    }
#undef IN
#undef BOTH
}

extern "C" void kernel_launch(void* const* d_in, const int* in_sizes, int n_in, void* d_out, int out_size, void* d_ws, size_t ws_size, hipStream_t stream) {
    static int grid = 0;
    if (grid == 0) {
        if (n_in != N_IN || in_sizes[0] != M * D || out_size != M * D || ws_size < WS_END) {
            fprintf(stderr, "kernel_launch: built for %d inputs, x/out of %d floats, >= %zu bytes of workspace; got n_in %d, in0 %d, out %d, ws %zu; nothing launched\n", N_IN, M * D, (size_t)WS_END, n_in, n_in > 0 ? in_sizes[0] : -1, out_size, ws_size);
            grid = -1; return; }
        int dev = 0, cus = 0, per_cu = 0;
        if (hipGetDevice(&dev) != hipSuccess || hipDeviceGetAttribute(&cus, hipDeviceAttributeMultiprocessorCount, dev) != hipSuccess) { fprintf(stderr, "kernel_launch: device query failed\n"); grid = -1; return; }
        if (hipFuncSetAttribute((const void*)fwd_kernel, hipFuncAttributeMaxDynamicSharedMemorySize, LDS_BYTES) != hipSuccess) { fprintf(stderr, "kernel_launch: hipFuncSetAttribute failed\n"); grid = -1; return; }
        if (hipOccupancyMaxActiveBlocksPerMultiprocessor(&per_cu, (const void*)fwd_kernel, NWAVES * 64, LDS_BYTES) != hipSuccess || per_cu < 1) {
            fprintf(stderr, "kernel_launch: occupancy query reports %d workgroups per CU; nothing launched\n", per_cu); (void)hipGetLastError(); grid = -1; return; }
        grid = cus;
    }
    if (grid < 0) return;
    if (hipMemsetAsync((char*)d_ws + WS_CTL, 0, CTL_ZERO_BYTES, stream) != hipSuccess) { fprintf(stderr, "kernel_launch: memset failed\n"); return; }
    Args a{};
    for (int i = 0; i < N_IN; ++i) a.in[i] = (const float*)d_in[i];
    a.out = (float*)d_out; a.ws = (unsigned char*)d_ws;
#if MK_PER_PHASE
    for (int p = 0; p < NPH; ++p) { a.ph_lo = p; a.ph_hi = p + 1; hipLaunchKernelGGL(fwd_kernel, dim3(grid), dim3(NWAVES * 64), LDS_BYTES, stream, a); }
#else
    a.ph_lo = 0; a.ph_hi = NPH;
    hipLaunchKernelGGL(fwd_kernel, dim3(grid), dim3(NWAVES * 64), LDS_BYTES, stream, a);
#endif
    const hipError_t le = hipPeekAtLastError();
    if (le != hipSuccess) fprintf(stderr, "kernel_launch: launch failed: %s\n", hipGetErrorName(le));
}
```

```cpp
#include <hip/hip_runtime.h>
#include <cstdio>
#include <cstdint>
#define MK_PER_PHASE 0
#ifndef PG8_SP2
#define PG8_SP2 true
#endif
#ifndef PG8_ALIGN
#define PG8_ALIGN true
#endif
#ifndef MK_PER_PHASE
#define MK_PER_PHASE 0
#endif
constexpr int NWAVES = 8;
constexpr int GRID_WG = 256;
constexpr int BATCH = 16, SEQ = 2048, D = 1024, DEPTH = 2, M = BATCH * SEQ;
constexpr int DIN = 2304, DFF = 2816, NGU = 2 * DFF;
constexpr int NH = 4;
constexpr float EPS = 1e-6f;
constexpr int NPH = 1 + 5 * DEPTH;
enum { I_X = 0, I_N1G, I_WIN, I_POOLW, I_POOLS, I_SCONVW, I_CDWW, I_CDWB, I_CLNG, I_CLNB, I_QNG, I_KNG, I_LQ1, I_LK1, I_LQ2, I_LK2, I_SUBG, I_WOUT, I_N2G, I_WGATE, I_WUP, I_WDOWN, I_RELB, N_IN };
constexpr size_t MiB = 1u << 20;
constexpr size_t WS_CTL = 0, CTL_ZERO_BYTES = 32768;
constexpr size_t WS_PART = 1 * MiB;
constexpr size_t WS_W = 4 * MiB, W_LAYER = 23 * MiB;
constexpr size_t WOFF_IN = 0, WOFF_OUT = (size_t)DIN * D * 2, WOFF_GU = WOFF_OUT + (size_t)D * D * 2, WOFF_DN = WOFF_GU + (size_t)NGU * D * 2;
static_assert(WOFF_DN + (size_t)D * DFF * 2 <= W_LAYER, "weight map");
constexpr size_t WS_XB = WS_W + DEPTH * W_LAYER;
constexpr size_t WS_ZC = WS_XB + (size_t)M * D * 2;
constexpr size_t WS_QN = WS_ZC + (size_t)M * D * 2;
constexpr size_t WS_KIMG = WS_QN + (size_t)M * 256 * 2;
constexpr size_t WS_VIMG = WS_KIMG + (size_t)M * 256 * 2;
constexpr size_t WS_MIX = WS_VIMG + (size_t)M * 256 * 2;
constexpr size_t WS_ACT = WS_MIX + (size_t)M * D * 2;
constexpr size_t WS_END = WS_ACT + (size_t)M * DFF * 2;
static_assert(WS_ACT + (size_t)M * DFF * 2 <= WS_END, "ACT overlay");
constexpr int CW_TMO = 0, CW_CODE = 1;
constexpr int CW_BAR = 4096;
constexpr int RING_OFF = 0, RING_BYTES = 131072;
constexpr int PHASE_LDS = 162816;
constexpr int LDSCTL_OFF = PHASE_LDS, MISC_OFF = LDSCTL_OFF + 320;
constexpr int LDS_BYTES = 163840;
static_assert(MISC_OFF + 128 <= LDS_BYTES, "LDS map");


__device__ __forceinline__ int mk_lane() { int l; asm volatile("v_mbcnt_lo_u32_b32 %0, -1, 0\n\tv_mbcnt_hi_u32_b32 %0, -1, %0" : "=v"(l)); return l; }
__device__ __forceinline__ int mk_tid(int wave) { return wave * 64 + mk_lane(); }
namespace pg8 {
#define PG8_LAS __attribute__((address_space(3)))
typedef unsigned short bf16_t;
typedef short bf16x8 __attribute__((ext_vector_type(8)));
typedef float f32x4 __attribute__((ext_vector_type(4)));
typedef unsigned u32x4 __attribute__((ext_vector_type(4)));
constexpr int BM = 256, BK = 64, HALF = 128, HTB = HALF * BK * 2  , STAGE_BYTES = 8 * HTB, NXCD = 8, WGM = 8;

__host__ __device__ __forceinline__ int lds_byte(int r, int c) { const int st = (r >> 4) * 2 + (c >> 5), rr = r & 15, cc = c & 31, ob = rr * 64 + cc * 2; return st * 1024 + (ob ^ (((ob >> 9) & 1) << 5)); }
__host__ __device__ __forceinline__ void stage_rc(int b, int& R, int& C) { const int st = b / 1024, sb = b % 1024, swz = sb ^ (((sb >> 9) & 1) << 5); R = (st >> 1) * 16 + swz / 64; C = (st & 1) * 32 + (swz % 64) / 2; }
__host__ __device__ __forceinline__ int perm32(int rho) { const int n = rho >> 4, i = rho & 15; return 8 * (i >> 2) + 4 * n + (i & 3); }

struct Unit { int pm, pn, hn; };
struct Gemm { const bf16_t* A; const bf16_t* Bt; int M, N, K; };

struct StaticOrder {
    int nM, nN, nwg, G, c, lim, rev = 0;
    __host__ __device__ void init(int M, int N, int G_, int c_) { nM = M / BM; nN = N / BM; nwg = nM * nN; G = G_; c = c_; lim = nwg; }
    __host__ __device__ bool next(int i, Unit& u) const {
        const long L = (long)i * G + c; if (L >= lim) return false; u.hn = 0;
        int wgid = (int)L; { const int q = nwg / NXCD, r = nwg % NXCD, xcd = wgid % NXCD; int off = wgid / NXCD; if (rev) off = (q + (xcd < r ? 1 : 0)) - 1 - off; wgid = (xcd < r ? xcd * (q + 1) : r * (q + 1) + (xcd - r) * q) + off; }
        const int nig = WGM * nN, gid = wgid / nig, fm = gid * WGM, gsz = (nM - fm) < WGM ? (nM - fm) : WGM;
        u.pm = fm + ((wgid % nig) % gsz); u.pn = (wgid % nig) / gsz; return true;
    }
    __device__ __forceinline__ void a_ready(const Unit&) const {}
    __device__ __forceinline__ void done(const Unit&) const {}
};

struct TailOrder {
    int c;
    __host__ __device__ bool next(int i, Unit& u) const {
        if (i != 0) return false;
        const int xcd = c % NXCD, j = c / NXCD, w = 128 + (j >> 1);
        u.pm = (2 * xcd + 1) * WGM + ((w - 72) % WGM); u.pn = (w - 72) / WGM; u.hn = j & 1; return true;
    }
    __device__ __forceinline__ void a_ready(const Unit&) const {}
    __device__ __forceinline__ void done(const Unit&) const {}
};

__device__ __forceinline__ unsigned cvt_pk_bf16(float lo, float hi) { unsigned r; asm volatile("v_cvt_pk_bf16_f32 %0, %1, %2" : "=v"(r) : "v"(lo), "v"(hi)); return r; }
typedef float f32x2 __attribute__((ext_vector_type(2)));

__device__ __forceinline__ float row_rstd(const float* part, int row, int fq) {
    const f32x4 p = *(const f32x4*)(part + (size_t)row * 16 + 4 * fq);
    float s = (p[0] + p[1]) + (p[2] + p[3]);
    s += __shfl_xor(s, 16); s += __shfl_xor(s, 32);
    return rsqrtf(s * (1.0f / 1024.0f) + 1e-6f);
}
struct RstdSrc {
    const PG8_LAS float* tab; int pmA;
    __device__ __forceinline__ float get(int pm, int rl  , int fq) const { return tab[(pm == pmA ? 0 : 256) + rl]; }
};
__device__ __forceinline__ float silu_f(float g) { return g * __builtin_amdgcn_rcpf(1.0f + __builtin_amdgcn_exp2f(-1.4426950408889634f * g)); }

struct EpiGLU {
    static constexpr bool PERM = true, AFTER_DRAIN = false; static constexpr int MIN_STORES = 8;
    bf16_t* O; int ldc; RstdSrc rsrc;
    __device__ __forceinline__ void operator()(const f32x4 (&acc)[2][2][4][2], const Unit& u, int wr, int wc, int fr, int fq) const {
        const int row0 = u.pm * BM + wr * 64 + fr, col0 = u.pn * HALF + wc * 32 + 8 * fq;
#pragma unroll
        for (int ai = 0; ai < 2; ++ai)
#pragma unroll
            for (int m = 0; m < 4; ++m) {
                const int row = row0 + ai * HALF + m * 16;
                const float rs = rsrc.get(u.pm, ai * HALF + wr * 64 + m * 16 + fr, fq);
                const float c1 = -1.4426950408889634f * rs, rs2 = rs * rs;
                f32x4 o[2];
#pragma unroll
                for (int n = 0; n < 2; ++n) { const f32x4 g = acc[ai][0][m][n], uu = acc[ai][1][m][n]; f32x4 e = g * c1;
#pragma unroll
                    for (int i = 0; i < 4; ++i) e[i] = __builtin_amdgcn_exp2f(e[i]);
                    e = e + 1.0f;
#pragma unroll
                    for (int i = 0; i < 4; ++i) e[i] = __builtin_amdgcn_rcpf(e[i]);
                    o[n] = (g * uu) * (e * rs2); }
                u32x4 w; w.x = cvt_pk_bf16(o[0][0], o[0][1]); w.y = cvt_pk_bf16(o[0][2], o[0][3]); w.z = cvt_pk_bf16(o[1][0], o[1][1]); w.w = cvt_pk_bf16(o[1][2], o[1][3]);
                *(u32x4*)(O + (size_t)row * ldc + col0) = w;
            }
    }
};
struct EpiRes {
    static constexpr bool PERM = true, AFTER_DRAIN = false; static constexpr int MIN_STORES = 24;
    unsigned char* ws; float* outf;
    __device__ __forceinline__ void operator()(const f32x4 (&acc)[2][2][4][2], const Unit& u, int wr, int wc, int fr, int fq) const {
        const int row0 = u.pm * BM + wr * 64 + fr, col0 = u.pn * BM + wc * 32 + 8 * fq;
        bf16_t* const xb = (bf16_t*)(ws + WS_XB); float* const part = (float*)(ws + WS_PART);
        u32x4 bw[2][4][2];
#pragma unroll
        for (int ai = 0; ai < 2; ++ai)
#pragma unroll
            for (int m = 0; m < 4; ++m)
#pragma unroll
                for (int bj = 0; bj < 2; ++bj) bw[ai][m][bj] = *(const u32x4*)(xb + (size_t)(row0 + ai * HALF + m * 16) * 1024 + col0 + bj * HALF);
        __builtin_amdgcn_sched_barrier(0);
#pragma unroll
        for (int ai = 0; ai < 2; ++ai)
#pragma unroll
            for (int m = 0; m < 4; ++m) {
                const int row = row0 + ai * HALF + m * 16; const size_t off = (size_t)row * 1024 + col0;
                float ss = 0.f;
#pragma unroll
                for (int bj = 0; bj < 2; ++bj) {
                    const u32x4 b = bw[ai][m][bj];
                    const f32x4 b0 = {__uint_as_float(b.x << 16), __uint_as_float(b.x & 0xffff0000u), __uint_as_float(b.y << 16), __uint_as_float(b.y & 0xffff0000u)};
                    const f32x4 b1 = {__uint_as_float(b.z << 16), __uint_as_float(b.z & 0xffff0000u), __uint_as_float(b.w << 16), __uint_as_float(b.w & 0xffff0000u)};
                    const f32x4 o0 = b0 + acc[ai][bj][m][0], o1 = b1 + acc[ai][bj][m][1];
                    if (outf) { __builtin_nontemporal_store(o0, (f32x4*)(outf + off + bj * HALF)); __builtin_nontemporal_store(o1, (f32x4*)(outf + off + bj * HALF + 4)); }
                    else { u32x4 w; w.x = cvt_pk_bf16(o0[0], o0[1]); w.y = cvt_pk_bf16(o0[2], o0[3]); w.z = cvt_pk_bf16(o1[0], o1[1]); w.w = cvt_pk_bf16(o1[2], o1[3]);
                        *(u32x4*)(xb + off + bj * HALF) = w; }
                    ss += ((o0[0] * o0[0] + o0[1] * o0[1]) + (o0[2] * o0[2] + o0[3] * o0[3])) + ((o1[0] * o1[0] + o1[1] * o1[1]) + (o1[2] * o1[2] + o1[3] * o1[3]));
                }
                ss += __shfl_xor(ss, 16); ss += __shfl_xor(ss, 32);
                if (fq == 0) part[(size_t)row * 16 + u.pn * 4 + wc] = ss;
            }
    }
};


constexpr float QSCALE_LOG2E = 0.17677669529663687f * 1.4426950408889634f;
struct EpiIn {
    static constexpr bool PERM = true, AFTER_DRAIN = false; static constexpr int MIN_STORES = 8;
    unsigned char* ws; RstdSrc rsrc; const float* qg; const float* kg;
    __device__ __forceinline__ void operator()(const f32x4 (&acc)[2][2][4][2], const Unit& u, int wr, int wc, int fr, int fq) const {
        const int row0 = u.pm * BM + wr * 64 + fr, pn = u.pn, c8 = wc * 32 + 8 * fq;
        bf16_t* const ZC = (bf16_t*)(ws + WS_ZC); bf16_t* const Qn = (bf16_t*)(ws + WS_QN); unsigned char* const Kimg = ws + WS_KIMG; unsigned char* const Vimg = ws + WS_VIMG;
        if (pn < 2) {
#pragma unroll
            for (int ai = 0; ai < 2; ++ai)
#pragma unroll
                for (int m = 0; m < 4; ++m) {
                    const int row = row0 + ai * HALF + m * 16; const float rs = rsrc.get(u.pm, ai * HALF + wr * 64 + m * 16 + fr, fq);
                    bf16_t* rowp = ZC + (size_t)row * 1024 + pn * 256 + c8;
#pragma unroll
                    for (int bj = 0; bj < 2; ++bj) {
                        const f32x4 v0 = acc[ai][bj][m][0] * rs, v1 = acc[ai][bj][m][1] * rs;
                        u32x4 w; w.x = cvt_pk_bf16(v0[0], v0[1]); w.y = cvt_pk_bf16(v0[2], v0[3]); w.z = cvt_pk_bf16(v1[0], v1[1]); w.w = cvt_pk_bf16(v1[2], v1[3]);
                        *(u32x4*)(rowp + bj * HALF) = w;
                    }
                }
        } else if (pn < 6) {
            const bool glu = pn >= 4; const int dcol = 512 + (glu ? 256 : 0) + ((pn - 2) & 1) * 128 + c8;
#pragma unroll
            for (int ai = 0; ai < 2; ++ai)
#pragma unroll
                for (int m = 0; m < 4; ++m) {
                    const int row = row0 + ai * HALF + m * 16; const float rs = rsrc.get(u.pm, ai * HALF + wr * 64 + m * 16 + fr, fq);
                    f32x4 o[2];
                    if (glu) { const float c1 = -1.4426950408889634f * rs;
#pragma unroll
                        for (int n = 0; n < 2; ++n) { f32x4 e = acc[ai][1][m][n] * c1;
#pragma unroll
                            for (int i = 0; i < 4; ++i) e[i] = __builtin_amdgcn_exp2f(e[i]);
                            e = e + 1.0f;
#pragma unroll
                            for (int i = 0; i < 4; ++i) e[i] = __builtin_amdgcn_rcpf(e[i]);
                            o[n] = (acc[ai][0][m][n] * rs) * e; } }
                    else { const float rs2 = rs * rs;
#pragma unroll
                        for (int n = 0; n < 2; ++n) o[n] = (acc[ai][0][m][n] * acc[ai][1][m][n]) * rs2; }
                    u32x4 w; w.x = cvt_pk_bf16(o[0][0], o[0][1]); w.y = cvt_pk_bf16(o[0][2], o[0][3]); w.z = cvt_pk_bf16(o[1][0], o[1][1]); w.w = cvt_pk_bf16(o[1][2], o[1][3]);
                    *(u32x4*)(ZC + (size_t)row * 1024 + dcol) = w;
                }
        } else if (pn < 8) {
            const float* gp = (pn == 6 ? qg : kg) + 8 * fq; const f32x4 g0 = *(const f32x4*)gp, g1 = *(const f32x4*)(gp + 4);
            const float osc = pn == 6 ? QSCALE_LOG2E : 1.0f;
#pragma unroll
            for (int ai = 0; ai < 2; ++ai)
#pragma unroll
                for (int m = 0; m < 4; ++m) {
                    const int row = row0 + ai * HALF + m * 16; const float rs = rsrc.get(u.pm, ai * HALF + wr * 64 + m * 16 + fr, fq);
#pragma unroll
                    for (int bj = 0; bj < 2; ++bj) {
                        const f32x4 v0 = acc[ai][bj][m][0] * rs, v1 = acc[ai][bj][m][1] * rs;
                        float ss = ((v0[0] * v0[0] + v0[1] * v0[1]) + (v0[2] * v0[2] + v0[3] * v0[3])) + ((v1[0] * v1[0] + v1[1] * v1[1]) + (v1[2] * v1[2] + v1[3] * v1[3]));
                        ss += __shfl_xor(ss, 16); ss += __shfl_xor(ss, 32);
                        const float rn = rsqrtf(ss * (1.0f / 32.0f) + 1e-6f) * osc;
                        const f32x4 o0 = v0 * rn * g0, o1 = v1 * rn * g1;
                        u32x4 w; w.x = cvt_pk_bf16(o0[0], o0[1]); w.y = cvt_pk_bf16(o0[2], o0[3]); w.z = cvt_pk_bf16(o1[0], o1[1]); w.w = cvt_pk_bf16(o1[2], o1[3]);
                        if (pn == 6) *(u32x4*)(Qn + (size_t)row * 256 + bj * HALF + c8) = w;
                        else { const int hm = 4 * bj + wc, b = row >> 11, t = row & 2047, kv = t & 63;
                            unsigned char* p = Kimg + ((size_t)((b * 4 + (hm >> 1)) * 32 + (t >> 6)) << 13) + kv * 128 + ((((hm & 1) * 4 + fq) ^ ((kv >> 1) & 7)) << 4);
                            *(u32x4*)p = w; }
                    }
                }
        } else {
#pragma unroll
            for (int ai = 0; ai < 2; ++ai)
#pragma unroll
                for (int m = 0; m < 4; ++m) {
                    const int row = row0 + ai * HALF + m * 16; const float rs = rsrc.get(u.pm, ai * HALF + wr * 64 + m * 16 + fr, fq);
                    const int b = row >> 11, t = row & 2047, kv = t & 63;
#pragma unroll
                    for (int bj = 0; bj < 2; ++bj) {
                        const f32x4 v0 = acc[ai][bj][m][0] * rs, v1 = acc[ai][bj][m][1] * rs;
                        u32x4 w; w.x = cvt_pk_bf16(v0[0], v0[1]); w.y = cvt_pk_bf16(v0[2], v0[3]); w.z = cvt_pk_bf16(v1[0], v1[1]); w.w = cvt_pk_bf16(v1[2], v1[3]);
                        unsigned char* p = Vimg + ((size_t)((b * 4 + 2 * bj + (wc >> 1)) * 32 + (t >> 6)) << 13) + 1024 * (kv >> 3) + 512 * (wc & 1) + 64 * (kv & 7) + 16 * fq;
                        *(u32x4*)p = w;
                    }
                }
        }
    }
};
struct EpiInTail {
    static constexpr bool PERM = true, AFTER_DRAIN = false; static constexpr int MIN_STORES = 0;
    unsigned char* ws; const float* kg;
    __device__ __forceinline__ void operator()(const f32x4 (&acc)[2][2][4][2], const Unit& u, int wr, int wc, int fr, int fq) const {
        const int row0 = u.pm * BM + wr * 64 + fr, bj = u.hn;
        unsigned char* const Kimg = ws + WS_KIMG; unsigned char* const Vimg = ws + WS_VIMG; const float* const part = (const float*)(ws + WS_PART);
        float rsv[2][4];
#pragma unroll
        for (int ai = 0; ai < 2; ++ai)
#pragma unroll
            for (int m = 0; m < 4; ++m) rsv[ai][m] = row_rstd(part, row0 + ai * HALF + m * 16, fq);
        if (u.pn == 7) {
            const float* gp = kg + 8 * fq; const f32x4 g0 = *(const f32x4*)gp, g1 = *(const f32x4*)(gp + 4);
#pragma unroll
            for (int ai = 0; ai < 2; ++ai)
#pragma unroll
                for (int m = 0; m < 4; ++m) {
                    const int row = row0 + ai * HALF + m * 16; const float rs = rsv[ai][m];
                    const f32x4 v0 = acc[ai][0][m][0] * rs, v1 = acc[ai][0][m][1] * rs;
                    float ss = ((v0[0] * v0[0] + v0[1] * v0[1]) + (v0[2] * v0[2] + v0[3] * v0[3])) + ((v1[0] * v1[0] + v1[1] * v1[1]) + (v1[2] * v1[2] + v1[3] * v1[3]));
                    ss += __shfl_xor(ss, 16); ss += __shfl_xor(ss, 32);
                    const float rn = rsqrtf(ss * (1.0f / 32.0f) + 1e-6f);
                    const f32x4 o0 = v0 * rn * g0, o1 = v1 * rn * g1;
                    u32x4 w; w.x = cvt_pk_bf16(o0[0], o0[1]); w.y = cvt_pk_bf16(o0[2], o0[3]); w.z = cvt_pk_bf16(o1[0], o1[1]); w.w = cvt_pk_bf16(o1[2], o1[3]);
                    const int hm = 4 * bj + wc, b = row >> 11, t = row & 2047, kv = t & 63;
                    unsigned char* p = Kimg + ((size_t)((b * 4 + (hm >> 1)) * 32 + (t >> 6)) << 13) + kv * 128 + ((((hm & 1) * 4 + fq) ^ ((kv >> 1) & 7)) << 4);
                    *(u32x4*)p = w;
                }
        } else {
#pragma unroll
            for (int ai = 0; ai < 2; ++ai)
#pragma unroll
                for (int m = 0; m < 4; ++m) {
                    const int row = row0 + ai * HALF + m * 16; const float rs = rsv[ai][m];
                    const int b = row >> 11, t = row & 2047, kv = t & 63;
                    const f32x4 v0 = acc[ai][0][m][0] * rs, v1 = acc[ai][0][m][1] * rs;
                    u32x4 w; w.x = cvt_pk_bf16(v0[0], v0[1]); w.y = cvt_pk_bf16(v0[2], v0[3]); w.z = cvt_pk_bf16(v1[0], v1[1]); w.w = cvt_pk_bf16(v1[2], v1[3]);
                    unsigned char* p = Vimg + ((size_t)((b * 4 + 2 * bj + (wc >> 1)) * 32 + (t >> 6)) << 13) + 1024 * (kv >> 3) + 512 * (wc & 1) + 64 * (kv & 7) + 16 * fq;
                    *(u32x4*)p = w;
                }
        }
    }
};
template <class Epi, class Sched, bool ALIGN_EPI = false, bool SP2 = false, bool HN = false, bool RS = false>
__device__ __forceinline__ void gemm_phase(PG8_LAS unsigned char* lds, const Gemm g, const Sched& S, const Epi& E, int wave_in, const float* rs_part = nullptr, PG8_LAS float* rs_tab = nullptr, int rs_pmA = -1, int rs_pmB = -1) {
    int tid_ = mk_tid(wave_in); asm volatile("" : "+v"(tid_));
    const int tid = tid_, wid = __builtin_amdgcn_readfirstlane(tid >> 6), lane = tid & 63, wr = wid >> 2, wc = wid & 3, fr = lane & 15, fq = lane >> 4;
    const int K = g.K, nt = K / BK;
    unsigned voffA[2], voffB[2];
#pragma unroll
    for (int i = 0; i < 2; ++i) { int R, C; stage_rc(tid * 16 + i * 8192, R, C); const int Rb = Epi::PERM ? ((R & ~31) + perm32(R & 31)) : R;
        voffA[i] = (unsigned)(R * K + C) * 2u; voffB[i] = (unsigned)(Rb * K + C) * 2u; }
    const size_t kstep = (size_t)(BK * 2);
    const size_t hstep = (size_t)HALF * K * 2;
    const size_t tstep = 2 * hstep;
    const unsigned ldsw = (unsigned)wid * 1024u;
    const int aoff = lds_byte(wr * 64 + fr, fq * 8), boff = lds_byte(wc * 32 + fr, fq * 8);
#define PG8_SA(b, h) (((b) * 2 + (h)) * HTB)
#define PG8_SB(b, h) ((4 + (b) * 2 + (h)) * HTB)
#define PG8_STAGE(bufoff, gbase, voff) do { _Pragma("unroll") for (int _i = 0; _i < 2; ++_i) \
        __builtin_amdgcn_global_load_lds((const unsigned*)((const char*)(gbase) + (voff)[_i]), (PG8_LAS unsigned*)(lds + (bufoff) + ldsw + _i * 8192), 16, 0, 0); } while (0)
#define PG8_LDA(dst, b, h) do { _Pragma("unroll") for (int m = 0; m < 4; ++m) _Pragma("unroll") for (int k = 0; k < 2; ++k) dst[m][k] = *(const PG8_LAS bf16x8*)(lds + PG8_SA(b, h) + aoff + m * 2048 + k * 1024); } while (0)
#define PG8_LDB(dst, b, h) do { _Pragma("unroll") for (int n = 0; n < 2; ++n) _Pragma("unroll") for (int k = 0; k < 2; ++k) dst[n][k] = *(const PG8_LAS bf16x8*)(lds + PG8_SB(b, h) + boff + n * 2048 + k * 1024); } while (0)
#define PG8_MMA(ai, bj, At, Bt) do { __builtin_amdgcn_s_setprio(1); _Pragma("unroll") for (int m = 0; m < 4; ++m) _Pragma("unroll") for (int n = 0; n < 2; ++n) _Pragma("unroll") for (int k = 0; k < 2; ++k) \
        acc[ai][bj][m][n] = __builtin_amdgcn_mfma_f32_16x16x32_bf16(Bt[n][k], At[m][k], acc[ai][bj][m][n], 0, 0, 0); __builtin_amdgcn_s_setprio(0); } while (0)
#define PG8_WAIT_V(n) asm volatile("s_waitcnt vmcnt(" #n ")" ::: "memory")
#define PG8_WAIT_V8_RELAX(f) do { if constexpr (Epi::MIN_STORES >= 24) asm volatile("s_waitcnt vmcnt(32)\n\ts_cmp_lg_u32 %0, 0\n\ts_cbranch_scc1 .Lpg8w_%=\n\ts_waitcnt vmcnt(8)\n.Lpg8w_%=:" :: "s"(f) : "memory", "scc"); \
        else asm volatile("s_waitcnt vmcnt(16)\n\ts_cmp_lg_u32 %0, 0\n\ts_cbranch_scc1 .Lpg8w_%=\n\ts_waitcnt vmcnt(8)\n.Lpg8w_%=:" :: "s"(f) : "memory", "scc"); } while (0)
#define PG8_WAIT_L(n) asm volatile("s_waitcnt lgkmcnt(" #n ")" ::: "memory")
#define PG8_BAR __builtin_amdgcn_s_barrier()
#define PG8_SCHED __builtin_amdgcn_sched_barrier(0)
    Unit cur, nxt; int ui = 0;
    if (!S.next(0, cur)) return;
    f32x4 rsq[4]; const int rs_pm = tid < 256 ? rs_pmA : rs_pmB;
    if constexpr (RS) { if (rs_pm >= 0) { const f32x4* p = (const f32x4*)(rs_part + ((size_t)rs_pm * 256 + (tid & 255)) * 16); rsq[0] = p[0]; rsq[1] = p[1]; rsq[2] = p[2]; rsq[3] = p[3]; } }
    f32x4 acc[2][2][4][2];
#pragma unroll
    for (int a = 0; a < 2; ++a)
#pragma unroll
        for (int b = 0; b < 2; ++b)
#pragma unroll
            for (int m = 0; m < 4; ++m)
#pragma unroll
                for (int n = 0; n < 2; ++n) acc[a][b][m][n] = (f32x4){0.f, 0.f, 0.f, 0.f};
    bf16x8 At[4][2], B0[2][2], B1[2][2];
    const char* cA = (const char*)g.A + (size_t)cur.pm * tstep; const char* cB = (const char*)g.Bt + (size_t)cur.pn * tstep + (HN ? (size_t)cur.hn * hstep : (size_t)0);
    S.a_ready(cur);
    if constexpr (HN) {
        PG8_STAGE(PG8_SB(0, 0), cB, voffB); PG8_STAGE(PG8_SA(0, 0), cA, voffA); PG8_STAGE(PG8_SA(0, 1), cA + hstep, voffA);
        if (wr == 1) PG8_BAR;
        PG8_WAIT_V(2); PG8_BAR;
        PG8_STAGE(PG8_SB(1, 0), cB + kstep, voffB); PG8_STAGE(PG8_SA(1, 0), cA + kstep, voffA);
        PG8_WAIT_V(4); PG8_BAR;
    } else if constexpr (SP2) {
        PG8_STAGE(PG8_SB(0, 0), cB, voffB); PG8_STAGE(PG8_SB(0, 1), cB + hstep, voffB); PG8_STAGE(PG8_SA(0, 0), cA, voffA); PG8_STAGE(PG8_SA(0, 1), cA + hstep, voffA);
        if (wr == 1) PG8_BAR;
        PG8_WAIT_V(2);
        if constexpr (RS) { if (rs_pm >= 0) { const f32x4 a = rsq[0], b = rsq[1], c = rsq[2], d = rsq[3];
            const float sq = (((a[0] + a[1]) + (a[2] + a[3])) + ((b[0] + b[1]) + (b[2] + b[3]))) + (((c[0] + c[1]) + (c[2] + c[3])) + ((d[0] + d[1]) + (d[2] + d[3])));
            rs_tab[tid] = rsqrtf(sq * (1.0f / 1024.0f) + 1e-6f); } }
        PG8_BAR;
        PG8_STAGE(PG8_SB(1, 0), cB + kstep, voffB); PG8_STAGE(PG8_SA(1, 0), cA + kstep, voffA); PG8_STAGE(PG8_SB(1, 1), cB + hstep + kstep, voffB);
        PG8_WAIT_V(6); PG8_BAR;
    } else {
        PG8_STAGE(PG8_SB(0, 0), cB, voffB); PG8_STAGE(PG8_SA(0, 0), cA, voffA); PG8_STAGE(PG8_SB(0, 1), cB + hstep, voffB); PG8_STAGE(PG8_SA(0, 1), cA + hstep, voffA);
        if (wr == 1) PG8_BAR;
        PG8_WAIT_V(4); PG8_BAR;
        PG8_STAGE(PG8_SB(1, 0), cB + kstep, voffB); PG8_STAGE(PG8_SA(1, 0), cA + kstep, voffA); PG8_STAGE(PG8_SB(1, 1), cB + hstep + kstep, voffB);
        PG8_WAIT_V(6); PG8_BAR;
    }
    for (;;) {
        const bool has_next = S.next(ui + 1, nxt);
        const char* nA = has_next ? (const char*)g.A + (size_t)nxt.pm * tstep : cA; const char* nB = has_next ? (const char*)g.Bt + (size_t)nxt.pn * tstep + (HN ? (size_t)nxt.hn * hstep : (size_t)0) : cB;
        for (int t = 0; t < nt; t += 2) {
            const bool last = (t == nt - 2);
            const char* a1 = cA + (size_t)(t + 1) * kstep;
            const char* a2 = last ? nA : cA + (size_t)(t + 2) * kstep; const char* b2 = last ? nB : cB + (size_t)(t + 2) * kstep;
            const char* a3 = a2 + kstep; const char* b3 = b2 + kstep;
            if (last && has_next) S.a_ready(nxt);
            const int fae = __builtin_amdgcn_readfirstlane((Epi::MIN_STORES >= 8 && t == 0 && ui > 0) ? 1 : 0);
            if constexpr (HN) {
            PG8_LDB(B0, 0, 0); PG8_SCHED; PG8_LDA(At, 0, 0); PG8_STAGE(PG8_SA(1, 1), a1 + hstep, voffA);
            PG8_WAIT_V(6); PG8_WAIT_L(0); PG8_BAR; PG8_MMA(0, 0, At, B0); PG8_BAR; PG8_SCHED;
            PG8_LDA(At, 0, 1); PG8_STAGE(PG8_SB(0, 0), b2, voffB); PG8_STAGE(PG8_SA(0, 0), a2, voffA);
            PG8_WAIT_V(6); PG8_WAIT_L(0); PG8_BAR; PG8_MMA(1, 0, At, B0); PG8_BAR; PG8_SCHED;
            PG8_LDB(B0, 1, 0); PG8_SCHED; PG8_LDA(At, 1, 0); PG8_STAGE(PG8_SA(0, 1), a2 + hstep, voffA);
            PG8_WAIT_V(6); PG8_WAIT_L(0); PG8_BAR; PG8_MMA(0, 0, At, B0); PG8_BAR; PG8_SCHED;
            PG8_LDA(At, 1, 1); PG8_STAGE(PG8_SB(1, 0), b3, voffB); PG8_STAGE(PG8_SA(1, 0), a3, voffA);
            PG8_WAIT_V(6); PG8_WAIT_L(0); PG8_BAR; PG8_MMA(1, 0, At, B0); PG8_BAR; PG8_SCHED;
            } else if constexpr (SP2) {
            PG8_LDB(B0, 0, 0); PG8_LDB(B1, 0, 1); PG8_SCHED; PG8_LDA(At, 0, 0); PG8_STAGE(PG8_SA(1, 1), a1 + hstep, voffA);
            PG8_WAIT_V8_RELAX(fae); PG8_WAIT_L(0); PG8_BAR; PG8_MMA(0, 0, At, B0); PG8_MMA(0, 1, At, B1); PG8_BAR; PG8_SCHED;
            PG8_LDA(At, 0, 1); PG8_STAGE(PG8_SB(0, 0), b2, voffB); PG8_STAGE(PG8_SB(0, 1), b2 + hstep, voffB); PG8_STAGE(PG8_SA(0, 0), a2, voffA);
            PG8_WAIT_V8_RELAX(fae); PG8_WAIT_L(0); PG8_BAR; PG8_MMA(1, 0, At, B0); PG8_MMA(1, 1, At, B1); PG8_BAR; PG8_SCHED;
            PG8_LDB(B0, 1, 0); PG8_LDB(B1, 1, 1); PG8_SCHED; PG8_LDA(At, 1, 0); PG8_STAGE(PG8_SA(0, 1), a2 + hstep, voffA);
            PG8_WAIT_V(8); PG8_WAIT_L(0); PG8_BAR; PG8_MMA(0, 0, At, B0); PG8_MMA(0, 1, At, B1); PG8_BAR; PG8_SCHED;
            PG8_LDA(At, 1, 1); PG8_STAGE(PG8_SB(1, 0), b3, voffB); PG8_STAGE(PG8_SB(1, 1), b3 + hstep, voffB); PG8_STAGE(PG8_SA(1, 0), a3, voffA);
            PG8_WAIT_V(8); PG8_WAIT_L(0); PG8_BAR; PG8_MMA(1, 0, At, B0); PG8_MMA(1, 1, At, B1); PG8_BAR; PG8_SCHED;
            } else {
            PG8_LDB(B0, 0, 0); PG8_SCHED; PG8_LDA(At, 0, 0); PG8_STAGE(PG8_SA(1, 1), a1 + hstep, voffA);
            PG8_WAIT_L(8); PG8_BAR; PG8_WAIT_L(0); PG8_MMA(0, 0, At, B0); PG8_BAR; PG8_SCHED;
            PG8_LDB(B1, 0, 1); PG8_STAGE(PG8_SB(0, 0), b2, voffB);
            PG8_BAR; PG8_WAIT_L(0); PG8_MMA(0, 1, At, B1); PG8_BAR;
            PG8_LDA(At, 0, 1); PG8_STAGE(PG8_SA(0, 0), a2, voffA);
            PG8_BAR; PG8_WAIT_L(0); PG8_MMA(1, 0, At, B0); PG8_BAR; PG8_SCHED;
            PG8_STAGE(PG8_SB(0, 1), b2 + hstep, voffB);
            PG8_WAIT_V(6); PG8_BAR; PG8_MMA(1, 1, At, B1); PG8_BAR;
            PG8_LDB(B0, 1, 0); PG8_SCHED; PG8_LDA(At, 1, 0); PG8_STAGE(PG8_SA(0, 1), a2 + hstep, voffA);
            PG8_WAIT_L(8); PG8_BAR; PG8_WAIT_L(0); PG8_MMA(0, 0, At, B0); PG8_BAR; PG8_SCHED;
            PG8_LDB(B1, 1, 1); PG8_STAGE(PG8_SB(1, 0), b3, voffB);
            PG8_BAR; PG8_WAIT_L(0); PG8_MMA(0, 1, At, B1); PG8_BAR;
            PG8_LDA(At, 1, 1); PG8_STAGE(PG8_SA(1, 0), a3, voffA);
            PG8_BAR; PG8_WAIT_L(0); PG8_MMA(1, 0, At, B0); PG8_BAR; PG8_SCHED;
            PG8_STAGE(PG8_SB(1, 1), b3 + hstep, voffB);
            PG8_WAIT_V(6); PG8_BAR; PG8_MMA(1, 1, At, B1); PG8_BAR;
            }
        }
        if constexpr (ALIGN_EPI) { if (wr == 0) PG8_BAR; }
        if constexpr (!Epi::AFTER_DRAIN) { E(acc, cur, wr, wc, fr, fq); S.done(cur); }
        if (!has_next) break;
#pragma unroll
        for (int a = 0; a < 2; ++a)
#pragma unroll
            for (int b = 0; b < 2; ++b)
#pragma unroll
                for (int m = 0; m < 4; ++m)
#pragma unroll
                    for (int n = 0; n < 2; ++n) acc[a][b][m][n] = (f32x4){0.f, 0.f, 0.f, 0.f};
        cur = nxt; cA = nA; cB = nB; ++ui;
        if constexpr (ALIGN_EPI) { if (wr == 1) PG8_BAR; }
    }
    PG8_WAIT_V(0);
    if constexpr (!ALIGN_EPI) { if (wr == 0) PG8_BAR; }
    PG8_BAR;
    if constexpr (Epi::AFTER_DRAIN) { E.fused(acc, cur, wr, wc, fr, fq, lds, wid, lane); S.done(cur); }
#undef PG8_SA
#undef PG8_SB
#undef PG8_STAGE
#undef PG8_LDA
#undef PG8_LDB
#undef PG8_MMA
#undef PG8_WAIT_V
#undef PG8_WAIT_V8_RELAX
#undef PG8_WAIT_L
#undef PG8_BAR
#undef PG8_SCHED
}
}
#define GAS __attribute__((address_space(1)))
#define LAS __attribute__((address_space(3)))
typedef unsigned short bf16;
typedef unsigned v4u __attribute__((ext_vector_type(4)));
typedef float f32x4 __attribute__((ext_vector_type(4)));
typedef short bf16x8 __attribute__((ext_vector_type(8)));
typedef GAS unsigned gu32;
typedef GAS unsigned long long gu64;
#define RLX_AGENT __ATOMIC_RELAXED, __HIP_MEMORY_SCOPE_AGENT
#define LDS_WAIT() asm volatile("s_waitcnt lgkmcnt(0)" ::: "memory")
#define VM_WAIT() asm volatile("s_waitcnt vmcnt(0)" ::: "memory")
__device__ __forceinline__ unsigned long long rt() { return __builtin_amdgcn_s_memrealtime(); }
__device__ __forceinline__ unsigned f2bf(float f) { unsigned u = __builtin_bit_cast(unsigned, f); return (u + 0x7fffu + ((u >> 16) & 1u)) >> 16; }
typedef float pk_f32x2_t __attribute__((ext_vector_type(2))); typedef __bf16 pk_bf16x2_t __attribute__((ext_vector_type(2)));
__device__ __forceinline__ unsigned pk2(float lo, float hi) { pk_f32x2_t v = {lo, hi}; pk_bf16x2_t b = __builtin_convertvector(v, pk_bf16x2_t); return __builtin_bit_cast(unsigned, b); }

#define XB_TMO      128
#define XB_XCNT(j)  (256  + 64 * (j))
#define XB_XSUB(j)  (1280 + 64 * (j))
#define XB_XGEN(j)  (2304 + 64 * (j))
#define XB_TOP      3328
#define XB_TOPGEN   3392
#define XCD_BAR_WORDS 3456
#define XB_SPIN_CAP (1u << 18)

__device__ __forceinline__ unsigned xb_ld(unsigned* p)              { return __hip_atomic_load(p, __ATOMIC_RELAXED, __HIP_MEMORY_SCOPE_AGENT); }
__device__ __forceinline__ unsigned xb_add(unsigned* p, unsigned v) { return __hip_atomic_fetch_add(p, v, __ATOMIC_RELAXED, __HIP_MEMORY_SCOPE_AGENT); }
__device__ __forceinline__ unsigned xb_xcc_id() { return (unsigned)__builtin_amdgcn_s_getreg((3 << 11) | 20) & 0xFu; }
#define XB_SPIN(cond, bar) do { unsigned _sp = 0; while (cond) { __builtin_amdgcn_s_sleep(1); \
    if ((++_sp & 255u) == 0u) { if (xb_ld(&(bar)[XB_TMO])) break; if (_sp > XB_SPIN_CAP) { atomicAdd(&(bar)[XB_TMO], 1u); break; } } } } while (0)

struct XcdBarrier {
    unsigned* bar; unsigned x; int wave;
    volatile LAS unsigned* st;
};

__device__ __forceinline__ XcdBarrier xcd_barrier_post(unsigned* bar, volatile LAS unsigned* st) {
    XcdBarrier b; b.bar = bar; b.x = xb_xcc_id(); b.st = st;
    if (threadIdx.x == 0) (void)xb_add(&bar[XB_XCNT(b.x)], 1u);
    return b;
}
__device__ __forceinline__ void xcd_barrier_complete(unsigned* bar, unsigned x, unsigned& nloc, unsigned& nx) {
    const unsigned G = gridDim.x * gridDim.y * gridDim.z;
    unsigned sum, cnt, mine, sp = 0u;
    for (;;) {
        sum = 0u; cnt = 0u; mine = 0u;
#pragma unroll
        for (unsigned j = 0; j < 16; ++j) { const unsigned c = xb_ld(&bar[XB_XCNT(j)]); sum += c; cnt += (c > 0u) ? 1u : 0u; mine = (j == x) ? c : mine; }
        if (sum == G) break;
        __builtin_amdgcn_s_sleep(1);
        if ((++sp & 255u) == 0u) { if (xb_ld(&bar[XB_TMO])) break; if (sp > XB_SPIN_CAP) { atomicAdd(&bar[XB_TMO], 1u); break; } }
    }
    nloc = mine > 0u ? mine : 1u; nx = cnt > 0u ? cnt : 1u;
}

__device__ __forceinline__ void xcd_barrier(const XcdBarrier& b) {
    asm volatile("s_waitcnt vmcnt(0)" ::: "memory");
    __syncthreads();
    if (b.wave == 0 && mk_lane() == 0) {
        unsigned* bar = b.bar;
        __builtin_amdgcn_s_waitcnt(0);
        unsigned nloc = b.st[0], nx = b.st[1];
        if (nloc == 0u) { xcd_barrier_complete(bar, b.x, nloc, nx); b.st[0] = nloc; b.st[1] = nx; }
        const unsigned old = xb_add(&bar[XB_XSUB(b.x)], 1u);
        const unsigned gen = old / nloc;
        if (old + 1u == (gen + 1u) * nloc) {
            __builtin_amdgcn_fence(__ATOMIC_RELEASE, "agent");
            asm volatile("s_waitcnt vmcnt(0)" ::: "memory");
            const unsigned og = xb_add(&bar[XB_TOP], 1u);
            const unsigned tg = og / nx;
            if (og + 1u == (tg + 1u) * nx) xb_add(&bar[XB_TOPGEN], 1u);
            else XB_SPIN(xb_ld(&bar[XB_TOPGEN]) == tg, bar);
            __builtin_amdgcn_fence(__ATOMIC_ACQUIRE, "agent");
            xb_add(&bar[XB_XGEN(b.x)], 1u);
            asm volatile("s_waitcnt vmcnt(0)" ::: "memory");
        } else {
            XB_SPIN(xb_ld(&bar[XB_XGEN(b.x)]) == gen, bar);
            __builtin_amdgcn_fence(__ATOMIC_ACQUIRE, "agent");
            asm volatile("s_waitcnt vmcnt(0)" ::: "memory");
        }
    }
    __syncthreads();
}

struct Args { const float* in[N_IN]; float* out; unsigned char* ws; int ph_lo, ph_hi, att_reps, conv_reps; };
static_assert(sizeof(Args) == N_IN * 8 + 8 + 8 + 16, "Args has no padding");
#define GB_CEN(g, x) (1024 + 16 * (g) + (x))
#define GB_SUB(g)    (2048 + 64 * (g))
#define GB_GEN(g)    (3072 + 64 * (g))
#define P0_ROWQ(g)   (3584 + 64 * (g))
__device__ __forceinline__ void group_barrier(unsigned* ctl, unsigned* bar, volatile LAS unsigned* st, int wave) {
    asm volatile("s_waitcnt vmcnt(0)" ::: "memory");
    __syncthreads();
    if (wave == 0 && mk_lane() == 0) {
        __builtin_amdgcn_s_waitcnt(0);
        const unsigned g = blockIdx.x & 7u, NG = GRID_WG / 8;
        unsigned mode = st[0];
        if (mode == 0u) {
            unsigned sp = 0u;
            for (;;) { unsigned sum = 0u, nz = 0u;
#pragma unroll
                for (unsigned j = 0; j < 16; ++j) { const unsigned c = xb_ld(&ctl[GB_CEN(g, j)]); sum += c; nz += (c > 0u) ? 1u : 0u; }
                if (sum == NG) { mode = nz == 1u ? 1u : 2u; break; }
                __builtin_amdgcn_s_sleep(1);
                if ((++sp & 255u) == 0u && (xb_ld(&bar[XB_TMO]) || sp > XB_SPIN_CAP)) { mode = 2u; break; } }
            st[0] = mode;
        }
        if (mode != 1u) { __builtin_amdgcn_fence(__ATOMIC_RELEASE, "agent"); asm volatile("s_waitcnt vmcnt(0)" ::: "memory"); }
        const unsigned old = xb_add(&ctl[GB_SUB(g)], 1u), gen = old / NG;
        if (old + 1u == (gen + 1u) * NG) xb_add(&ctl[GB_GEN(g)], 1u);
        else XB_SPIN(xb_ld(&ctl[GB_GEN(g)]) == gen, bar);
        __builtin_amdgcn_fence(__ATOMIC_ACQUIRE, "agent");
        asm volatile("s_waitcnt vmcnt(0)" ::: "memory");
    }
    __syncthreads();
}

struct Frame {
    LAS unsigned char* lds;
    volatile LAS unsigned* MISC;
    gu32* ctl;
    int tid, lane, wave;
    int vcu, G;
    unsigned char* ws;
};
__device__ __forceinline__ bf16* w_ptr(const Frame& F, int l, size_t off) { return (bf16*)(F.ws + WS_W + (size_t)l * W_LAYER + off); }
__device__ __forceinline__ float bf2f(bf16 v) { return __uint_as_float((unsigned)v << 16); }
__device__ __forceinline__ float wave_sum(float v) {
#pragma unroll
    for (int o = 1; o < 64; o <<= 1) v += __shfl_xor(v, o);
    return v;
}
__device__ __forceinline__ float wave_max(float v) {
#pragma unroll
    for (int o = 1; o < 64; o <<= 1) v = fmaxf(v, __shfl_xor(v, o));
    return v;
}
__device__ const unsigned char REL_BUCKET_TAB[128] = {
    0, 1, 2, 3, 4, 5, 6, 7, 8, 9, 10, 11, 12, 13, 14, 15, 16, 16, 16, 17, 17, 18, 18, 18, 19, 19, 19, 20, 20, 20, 20, 21, 21, 21, 21, 22, 22, 22, 22, 22, 23, 23, 23, 23, 23, 23, 24, 24, 24, 24, 24, 24,
    25, 25, 25, 25, 25, 25, 25, 26, 26, 26, 26, 26, 26, 26, 26, 27, 27, 27, 27, 27, 27, 27, 27, 27, 27, 28, 28, 28, 28, 28, 28, 28, 28, 28, 28, 29, 29, 29, 29, 29, 29, 29, 29, 29, 29, 29, 29,
    30, 30, 30, 30, 30, 30, 30, 30, 30, 30, 30, 30, 30, 30, 31, 31, 31, 31, 31, 31, 31, 31, 31, 31, 31, 31, 31, 31, 31};

__device__ __forceinline__ void st16_wt(void* p, v4u v) { asm volatile("global_store_dwordx4 %0, %1, off sc0 sc1\n\ts_nop 1" :: "v"(p), "v"(v) : "memory"); }
struct TItem { const float* W; const float* gain; bf16* WT; int K, N, dst, k0, n0; };
__device__ __forceinline__ void titem_load(const TItem& t, float (&v)[32], int lane) {
    const unsigned loff = (unsigned)((lane >> 5) * t.N + (lane & 31));
#pragma unroll
    for (int i = 0; i < 32; ++i) { const float* rp = t.W + (size_t)(t.k0 + 2 * i) * t.N + t.n0; v[i] = __builtin_nontemporal_load(rp + loff); }
}
__device__ __forceinline__ void titem_finish(const TItem& t, const float (&v)[32], LAS float* scr, int lane) {
#pragma unroll
    for (int i = 0; i < 32; ++i) { const int kk = 2 * i + (lane >> 5); float x = v[i]; if (t.gain) x *= t.gain[t.k0 + kk]; scr[kk * 33 + (lane & 31)] = x; }
    LDS_WAIT(); asm volatile("" ::: "memory");
    const int c = lane & 7;
#pragma unroll
    for (int j = 0; j < 4; ++j) { const int n = (lane >> 3) + 8 * j; const LAS float* s = scr + (8 * c) * 33 + n;
        v4u o; o.x = pk2(s[0 * 33], s[1 * 33]); o.y = pk2(s[2 * 33], s[3 * 33]); o.z = pk2(s[4 * 33], s[5 * 33]); o.w = pk2(s[6 * 33], s[7 * 33]);
        st16_wt((void*)(t.WT + (size_t)(t.dst + n) * t.K + t.k0 + 8 * c), o); }
    LDS_WAIT(); asm volatile("" ::: "memory");
}
__device__ __forceinline__ void p0_poolfold_item(const float* Wout, const float* pw, const float* ps, bf16* WT, int g, int n0, LAS float* scr, int lane_) {
    int lane = lane_; asm volatile("" : "+v"(lane));
    { const float* wr = Wout + (size_t)(g * 64 + lane) * D + n0; const float sc = ps[g * 64 + lane];
      *(LAS f32x4*)(scr + lane * 8) = *(const f32x4*)wr * sc; *(LAS f32x4*)(scr + lane * 8 + 4) = *(const f32x4*)(wr + 4) * sc; }
    LDS_WAIT(); asm volatile("" ::: "memory");
    f32x4 a0 = {0.f, 0.f, 0.f, 0.f}, a1 = {0.f, 0.f, 0.f, 0.f};
#pragma unroll 1
    for (int q = 0; q < 4; ++q) {
        f32x4 pr[4];
#pragma unroll
        for (int j = 0; j < 4; ++j) pr[j] = *(const f32x4*)(pw + (size_t)(g * 64 + lane) * 64 + 16 * q + 4 * j);
#pragma unroll
        for (int dd = 0; dd < 16; ++dd) { const float p = pr[dd >> 2][dd & 3]; const LAS float* sp = scr + (16 * q + dd) * 8; a0 += *(const LAS f32x4*)sp * p; a1 += *(const LAS f32x4*)(sp + 4) * p; }
    }
    bf16* o = WT + (size_t)n0 * D + g * 64 + lane;
#pragma unroll
    for (int e = 0; e < 4; ++e) { o[(size_t)e * D] = (bf16)f2bf(a0[e]); o[(size_t)(4 + e) * D] = (bf16)f2bf(a1[e]); }
    LDS_WAIT(); asm volatile("" ::: "memory");
}
constexpr int I_IN = (D / 64) * (DIN / 32), I_OUTT = (D / 64 - 4) * (D / 32), I_G = (D / 64) * (DFF / 32), I_DN = (DFF / 64) * (D / 32), PER_L = I_IN + I_OUTT + 2 * I_G + I_DN, I_FOLD = 4 * (D / 8);
__device__ __forceinline__ TItem titem_decode(Frame& F, const Args& A, int it) {
    const int l = it / PER_L; int r = it % PER_L; TItem t;
    if (r < I_IN) { const int nb = DIN / 32, kb = r / nb, n0 = 32 * (r % nb);
        int dst = n0;
        if (n0 >= 512 && n0 < 1536) { const int q4 = (n0 - 512) >> 8, j = (n0 - 512) & 255; dst = 512 + 512 * (q4 >> 1) + 256 * (j >> 7) + 128 * (q4 & 1) + (j & 127); }
        t = TItem{A.in[I_WIN] + (size_t)l * D * DIN, A.in[I_N1G] + l * D, w_ptr(F, l, WOFF_IN), D, DIN, dst, 64 * kb, n0}; return t; } r -= I_IN;
    if (r < I_OUTT) { const int nb = D / 32, kb = 4 + r / nb, n0 = 32 * (r % nb);
        t = TItem{A.in[I_WOUT] + (size_t)l * D * D, nullptr, w_ptr(F, l, WOFF_OUT), D, D, n0, 64 * kb, n0}; return t; } r -= I_OUTT;
    if (r < 2 * I_G) { const int up = r >= I_G; if (up) r -= I_G; const int nb = DFF / 32, kb = r / nb, n0 = 32 * (r % nb);
        const int dst = 256 * (n0 / 128) + 128 * up + (n0 % 128);
        t = TItem{A.in[up ? I_WUP : I_WGATE] + (size_t)l * D * DFF, A.in[I_N2G] + l * D, w_ptr(F, l, WOFF_GU), D, DFF, dst, 64 * kb, n0}; return t; } r -= 2 * I_G;
    { const int nb = D / 32, kb = r / nb, n0 = 32 * (r % nb);
        t = TItem{A.in[I_WDOWN] + (size_t)l * DFF * D, nullptr, w_ptr(F, l, WOFF_DN), DFF, D, n0, 64 * kb, n0}; return t; }
}
__device__ __forceinline__ void p0_weight_items(Frame& F, const Args& A, int gw, int NGW, int wave, int lane) {
    LAS float* scr = (LAS float*)(F.lds + RING_OFF + wave * 16384);
    for (int k = gw; k < DEPTH * I_FOLD; k += NGW) { const int l = k / I_FOLD, r = k % I_FOLD;
        p0_poolfold_item(A.in[I_WOUT] + (size_t)l * D * D, A.in[I_POOLW] + (size_t)l * 4 * 64 * 64, A.in[I_POOLS] + l * 256, w_ptr(F, l, WOFF_OUT), r / (D / 8), 8 * (r % (D / 8)), scr, lane); }
    for (int k = gw; k < DEPTH * PER_L; k += 2 * NGW) {
        const TItem t0 = titem_decode(F, A, k); float v0[32], v1[32]; titem_load(t0, v0, lane);
        const bool two = k + NGW < DEPTH * PER_L; const TItem t1 = titem_decode(F, A, two ? k + NGW : k);
        if (two) titem_load(t1, v1, lane);
        titem_finish(t0, v0, scr, lane);
        if (two) titem_finish(t1, v1, scr, lane);
    }
}
__device__ __forceinline__ void p0_prologue(Frame& F, const Args& A) {
    int tid_ = mk_tid(F.wave); asm volatile("" : "+v"(tid_));
    const int lane = tid_ & 63, wave = __builtin_amdgcn_readfirstlane(tid_ >> 6);
    const int gw = F.vcu * NWAVES + wave, NGW = F.G * NWAVES;
    p0_weight_items(F, A, (int)(blockIdx.x & (GRID_WG - 1)) * NWAVES + wave, NGW, wave, lane);
    const float* x = A.in[I_X];
    unsigned* const rq = (unsigned*)F.ctl + P0_ROWQ(blockIdx.x & 7u);
    const int rbase = (int)(blockIdx.x & 7u) * (M / 8);
#define P0_FETCH(raw) do { raw = 0u; if (lane == 0) raw = __hip_atomic_fetch_add(rq, 1u, __ATOMIC_RELAXED, __HIP_MEMORY_SCOPE_AGENT); } while (0)
    unsigned fr; P0_FETCH(fr);
    int c = __builtin_amdgcn_readfirstlane((int)fr);
    while (c < M / 8 / 4) {
        unsigned fn; P0_FETCH(fn);
        const int m0 = rbase + 4 * c;
        f32x4 v[4][4];
#pragma unroll
        for (int q = 0; q < 4; ++q) { const int m = m0 + q; const GAS f32x4* xr = (const GAS f32x4*)(x + (size_t)m * D) + 2 * lane;
#pragma unroll
            for (int h = 0; h < 2; ++h) { v[q][2 * h] = __builtin_nontemporal_load(xr + 128 * h); v[q][2 * h + 1] = __builtin_nontemporal_load(xr + 128 * h + 1); } }
#pragma unroll
        for (int q = 0; q < 4; ++q) { const int m = m0 + q; float s = 0.f;
#pragma unroll
            for (int j = 0; j < 4; ++j) s += (v[q][j].x * v[q][j].x + v[q][j].y * v[q][j].y) + (v[q][j].z * v[q][j].z + v[q][j].w * v[q][j].w);
            s = wave_sum(s);
            bf16* xbr = ((bf16*)(F.ws + WS_XB)) + (size_t)m * D;
#pragma unroll
            for (int h = 0; h < 2; ++h) { v4u o; o.x = pk2(v[q][2 * h].x, v[q][2 * h].y); o.y = pk2(v[q][2 * h].z, v[q][2 * h].w); o.z = pk2(v[q][2 * h + 1].x, v[q][2 * h + 1].y); o.w = pk2(v[q][2 * h + 1].z, v[q][2 * h + 1].w);
                st16_wt((void*)(xbr + 512 * h + 8 * lane), o); }
            if (lane < 16) ((float*)(F.ws + WS_PART))[(size_t)m * 16 + lane] = (lane == 0) ? s : 0.f; }
        c = __builtin_amdgcn_readfirstlane((int)fn);
    }
#undef P0_FETCH
}

namespace att {
typedef short bf16x8 __attribute__((ext_vector_type(8)));
typedef float f32x16 __attribute__((ext_vector_type(16)));
typedef short v4s __attribute__((ext_vector_type(4)));
constexpr int SLOTB = 16384, NSLOT = 3, TAB_OFF = NSLOT * SLOTB;
constexpr float LOG2E = 1.4426950408889634f;
__device__ __forceinline__ void glds16(const void* gsrc, unsigned lds_dst) { unsigned keep;
    asm volatile("s_mov_b32 %0, m0\n\ts_mov_b32 m0, %2\n\ts_nop 0\n\tglobal_load_lds_dwordx4 %1, off\n\ts_mov_b32 m0, %0" : "=&s"(keep) : "v"(gsrc), "s"(lds_dst) : "memory"); }
typedef float f32x2_t __attribute__((ext_vector_type(2))); typedef __bf16 bf16x2_t __attribute__((ext_vector_type(2)));
__device__ __forceinline__ unsigned cvtpk(float lo, float hi) { f32x2_t v = {lo, hi}; bf16x2_t b = __builtin_convertvector(v, bf16x2_t); return __builtin_bit_cast(unsigned, b); }
template <int ABL> __device__ __forceinline__ void attn_unit(LAS unsigned char* lds, const bf16* Qn, const unsigned char* Kimg, const unsigned char* Vimg, bf16* MIX, const float* relb, const float* subg,
                                          int b, int h, int qb, float negB, float lam, float oml, int tid, int lane, int wid) {
    (void)relb; (void)subg;
    const int ql = lane & 31, hh = lane >> 5;
    const int qw = qb * 256 + 32 * wid;
    const int NT = 4 * qb + 4, jl = 4 * qb + (wid >> 1);
    const LAS unsigned char* rtab = lds + TAB_OFF + 256 + h * 1280;
    const LAS float* sgl = (const LAS float*)(lds + TAB_OFF);
    const size_t rowq = (size_t)b * SEQ + qw + ql;
    const unsigned char* ksrc = Kimg + ((size_t)((b * 4 + h) * 32) << 13) + wid * 1024 + lane * 16;
    const unsigned char* vsrc = Vimg + ((size_t)((b * 4 + h) * 32) << 13) + wid * 1024 + lane * 16;
    const unsigned ldsb = (unsigned)(uintptr_t)lds;
#define ATT_DMA(t, slot) do { \
        glds16(ksrc + ((size_t)(t) << 13), (unsigned)__builtin_amdgcn_readfirstlane(ldsb + (slot) * SLOTB + wid * 1024)); \
        glds16(vsrc + ((size_t)(t) << 13), (unsigned)__builtin_amdgcn_readfirstlane(ldsb + (slot) * SLOTB + 8192 + wid * 1024)); } while (0)
    f32x16 O[2][2];
#pragma unroll
    for (int m = 0; m < 2; ++m)
#pragma unroll
        for (int d = 0; d < 2; ++d)
#pragma unroll
            for (int r = 0; r < 16; ++r) O[m][d][r] = 0.f;
    float l0 = 0.f, l1 = 0.f;
    (void)negB;
    ATT_DMA(0, 0); ATT_DMA(1, 1);
    bf16x8 qf[2][2];
#pragma unroll
    for (int m = 0; m < 2; ++m)
#pragma unroll
        for (int s = 0; s < 2; ++s) qf[m][s] = *(const bf16x8*)(Qn + rowq * 256 + (2 * h + m) * 32 + 16 * s + 8 * hh);
    __builtin_amdgcn_s_waitcnt(0x0F70);
    int slot = 0, slot2 = 2;
    for (int t = 0; t < NT; ++t) {
        if (t + 1 < NT) asm volatile("s_waitcnt vmcnt(2) lgkmcnt(0)" ::: "memory"); else asm volatile("s_waitcnt vmcnt(0) lgkmcnt(0)" ::: "memory");
        __builtin_amdgcn_s_barrier(); asm volatile("" ::: "memory");
        if (t + 2 < NT) ATT_DMA(t + 2, slot2);
        if (t <= jl) {
            const LAS unsigned char* kS = lds + slot * SLOTB; const LAS unsigned char* vS = kS + 8192;
            const int vlane = 64 * (4 * hh + ((lane & 15) >> 2)) + 32 * ((lane >> 4) & 1) + 8 * (lane & 3);
            const bool near = qw - (64 * t + 63) < 113;
            const LAS float* rp = (const LAS float*)(rtab + 4 * (224 - ((qw + ql) - 64 * t - 4 * hh)));
            bf16x8 kf[2][2][2];
#pragma unroll
            for (int m = 0; m < 2; ++m)
#pragma unroll
                for (int blk = 0; blk < 2; ++blk)
#pragma unroll
                    for (int s = 0; s < 2; ++s) { const int kv = 32 * blk + ql; kf[m][blk][s] = *(const LAS bf16x8*)(kS + kv * 128 + (((m * 4 + 2 * s + hh) ^ ((kv >> 1) & 7)) << 4)); }
            __builtin_amdgcn_sched_barrier(0);
            f32x16 S[2][2]; bf16x8 pk[2][2][2];
#define ATT_SMAP(m) do { f32x16 z0, z1; _Pragma("unroll") for (int r = 0; r < 16; ++r) { z0[r] = 0.f; z1[r] = 0.f; } \
                z0 = __builtin_amdgcn_mfma_f32_32x32x16_bf16(kf[m][0][0], qf[m][0], z0, 0, 0, 0); z1 = __builtin_amdgcn_mfma_f32_32x32x16_bf16(kf[m][1][0], qf[m][0], z1, 0, 0, 0); \
                S[m][0] = __builtin_amdgcn_mfma_f32_32x32x16_bf16(kf[m][0][1], qf[m][1], z0, 0, 0, 0); S[m][1] = __builtin_amdgcn_mfma_f32_32x32x16_bf16(kf[m][1][1], qf[m][1], z1, 0, 0, 0); } while (0)
#define ATT_BIAS(m) do { if (near) { _Pragma("unroll") for (int blk = 0; blk < 2; ++blk) { float bv[16]; \
                _Pragma("unroll") for (int r = 0; r < 16; ++r) bv[r] = rp[32 * blk + (r & 3) + 8 * (r >> 2)]; \
                _Pragma("unroll") for (int r = 0; r < 16; ++r) S[m][blk][r] += bv[r]; } } } while (0)
#define ATT_EXPMAP(m, lacc) do { _Pragma("unroll") for (int blk = 0; blk < 2; ++blk) { float ls[4] = {0.f, 0.f, 0.f, 0.f};     \
                _Pragma("unroll") for (int r = 0; r < 16; ++r) { const float p = __builtin_amdgcn_exp2f(S[m][blk][r]); S[m][blk][r] = p; ls[r & 3] += p; } \
                lacc += (ls[0] + ls[1]) + (ls[2] + ls[3]); \
                _Pragma("unroll") for (int s = 0; s < 2; ++s) { v4u w; \
                    w.x = cvtpk(S[m][blk][8 * s + 0], S[m][blk][8 * s + 1]); w.y = cvtpk(S[m][blk][8 * s + 2], S[m][blk][8 * s + 3]); \
                    w.z = cvtpk(S[m][blk][8 * s + 4], S[m][blk][8 * s + 5]); w.w = cvtpk(S[m][blk][8 * s + 6], S[m][blk][8 * s + 7]); \
                    pk[m][blk][s] = __builtin_bit_cast(bf16x8, w); } } } while (0)
            ATT_SMAP(0);
            __builtin_amdgcn_sched_barrier(0);
            ATT_BIAS(0);
            __builtin_amdgcn_sched_barrier(0);
            ATT_SMAP(1);
            ATT_EXPMAP(0, l0);
#pragma unroll
            for (int g = 0; g < 4; ++g) { __builtin_amdgcn_sched_group_barrier(0x008, 1, 0); __builtin_amdgcn_sched_group_barrier(0x002, 16, 0); }
            __builtin_amdgcn_sched_barrier(0);
            ATT_BIAS(1);
            v4s vlo[2][2][2], vhi[2][2][2];
#pragma unroll
            for (int db = 0; db < 2; ++db)
#pragma unroll
                for (int blk = 0; blk < 2; ++blk)
#pragma unroll
                    for (int s = 0; s < 2; ++s) { const LAS unsigned char* vp = vS + vlane + 1024 * (4 * blk + 2 * s) + 512 * db;
                        vlo[db][blk][s] = __builtin_bit_cast(v4s, __builtin_amdgcn_ds_read_tr16_b64_v4i16((LAS v4s*)vp)); vhi[db][blk][s] = __builtin_bit_cast(v4s, __builtin_amdgcn_ds_read_tr16_b64_v4i16((LAS v4s*)(vp + 1024))); }
            __builtin_amdgcn_sched_barrier(0);
#pragma unroll
            for (int db = 0; db < 2; ++db)
#pragma unroll
                for (int blk = 0; blk < 2; ++blk)
#pragma unroll
                    for (int s = 0; s < 2; ++s) { const v4s lo = vlo[db][blk][s], hi = vhi[db][blk][s];
                        const bf16x8 vf = (bf16x8){lo[0], lo[1], lo[2], lo[3], hi[0], hi[1], hi[2], hi[3]};
                        O[0][db] = __builtin_amdgcn_mfma_f32_32x32x16_bf16(vf, pk[0][blk][s], O[0][db], 0, 0, 0); }
            ATT_EXPMAP(1, l1);
#pragma unroll
            for (int g = 0; g < 8; ++g) { __builtin_amdgcn_sched_group_barrier(0x008, 1, 0); __builtin_amdgcn_sched_group_barrier(0x002, 8, 0); }
            __builtin_amdgcn_sched_barrier(0);
#pragma unroll
            for (int db = 0; db < 2; ++db)
#pragma unroll
                for (int blk = 0; blk < 2; ++blk)
#pragma unroll
                    for (int s = 0; s < 2; ++s) { const v4s lo = vlo[db][blk][s], hi = vhi[db][blk][s];
                        const bf16x8 vf = (bf16x8){lo[0], lo[1], lo[2], lo[3], hi[0], hi[1], hi[2], hi[3]};
                        O[1][db] = __builtin_amdgcn_mfma_f32_32x32x16_bf16(vf, pk[1][blk][s], O[1][db], 0, 0, 0); }
            __builtin_amdgcn_sched_barrier(0);
#undef ATT_SMAP
#undef ATT_BIAS
#undef ATT_EXPMAP
        }
        slot = slot == NSLOT - 1 ? 0 : slot + 1; slot2 = slot2 == NSLOT - 1 ? 0 : slot2 + 1;
    }
#undef ATT_DMA
    l0 += __shfl_xor(l0, 32); l1 += __shfl_xor(l1, 32);
    const float i0 = 1.0f / l0, i1 = lam / l1;
    float ss = 0.f;
#pragma unroll
    for (int db = 0; db < 2; ++db)
#pragma unroll
        for (int r = 0; r < 16; ++r) { const float v = O[0][db][r] * i0 - O[1][db][r] * i1; O[0][db][r] = v; ss += v * v; }
    ss += __shfl_xor(ss, 32);
    const float rn = rsqrtf(ss * (1.0f / 64.0f) + EPS) * oml;
    bf16* orow = MIX + rowq * D + 768 + h * 64;
#pragma unroll
    for (int db = 0; db < 2; ++db)
#pragma unroll
        for (int g4 = 0; g4 < 4; ++g4) { const int d0 = 32 * db + 8 * g4 + 4 * hh; const f32x4 gg = *(const LAS f32x4*)(sgl + d0);
            const unsigned lo = cvtpk(O[0][db][4 * g4 + 0] * rn * gg[0], O[0][db][4 * g4 + 1] * rn * gg[1]), hi = cvtpk(O[0][db][4 * g4 + 2] * rn * gg[2], O[0][db][4 * g4 + 3] * rn * gg[3]);
            *(unsigned long long*)(orow + d0) = (unsigned long long)lo | ((unsigned long long)hi << 32); }
    asm volatile("s_waitcnt lgkmcnt(0)" ::: "memory"); __builtin_amdgcn_s_barrier(); asm volatile("" ::: "memory");
}
}

constexpr int CONV_US = 0, CONV_CS = 49152, CONV_WS = 114688;
static_assert(CONV_WS + 31 * 256 * 4 <= PHASE_LDS, "conv LDS map");
__device__ __forceinline__ void conv_unit(LAS unsigned char* lds, const bf16* ZC, bf16* MIX, const float* sconv_w, const float* cdw_b, const float* cln_g, const float* cln_b,
                                          int b, int ch, int tid, int lane, int wid) {
    const int t0 = ch * 64; const size_t row0 = (size_t)b * SEQ + t0;
    LAS unsigned* Us = (LAS unsigned*)(lds + CONV_US);
    LAS float* Cs = (LAS float*)(lds + CONV_CS);
    const LAS float* Ws = (const LAS float*)(lds + CONV_WS);
    { v4u v[6];
#pragma unroll
      for (int k = 0; k < 6; ++k) { const int i = tid + k * NWAVES * 64, r = i >> 5, c16 = i & 31; v[k] = (v4u){0u, 0u, 0u, 0u};
          if (i < 94 * 32 && t0 - 30 + r >= 0) v[k] = *(const v4u*)(ZC + (row0 - 30 + r) * 1024 + 768 + c16 * 8); }
#pragma unroll
      for (int k = 0; k < 6; ++k) { const int i = tid + k * NWAVES * 64; if (i < 94 * 32) *(LAS v4u*)(lds + CONV_US + (i >> 5) * 512 + (i & 31) * 16) = v[k]; } }
    { const int g = wid & 3, win = 2 << g, cg = 8 * g + (lane & 7), tq = (lane >> 3) + 8 * (wid >> 2), pos = t0 + 4 * tq; const size_t row = row0 + 4 * tq;
      const bf16* zp = ZC + row * 1024 + 8 * cg;
      float s[8];
#pragma unroll
      for (int e = 0; e < 8; ++e) s[e] = 0.f;
      { v4u wv[15];
#pragma unroll
        for (int j = 1; j < 16; ++j) { wv[j - 1] = (v4u){0u, 0u, 0u, 0u}; if (j < win && pos - j >= 0) wv[j - 1] = *(const v4u*)(zp - (size_t)j * 1024); }
#pragma unroll
        for (int j = 0; j < 15; ++j)
#pragma unroll
          for (int e = 0; e < 4; ++e) { s[2 * e] += __uint_as_float(wv[j][e] << 16); s[2 * e + 1] += __uint_as_float(wv[j][e] & 0xffff0000u); } }
      v4u cur[4], old[4], pp[6], sb[4];
#pragma unroll
      for (int i = 0; i < 4; ++i) { cur[i] = *(const v4u*)(zp + (size_t)i * 1024); old[i] = (v4u){0u, 0u, 0u, 0u};
          if (pos + i + 1 >= win) old[i] = *(const v4u*)(zp + (size_t)i * 1024 - (size_t)(win - 1) * 1024);
          sb[i] = *(const v4u*)(zp + (size_t)i * 1024 + 256 + 0); }
#pragma unroll
      for (int i = 0; i < 6; ++i) { pp[i] = (v4u){0u, 0u, 0u, 0u}; if (pos - 2 + i >= 0) pp[i] = *(const v4u*)(ZC + (row - 2 + i) * 1024 + 512 + 8 * cg); }
      float w0[8], w1[8], w2[8];
#pragma unroll
      for (int e = 0; e < 8; e += 4) { const f32x4 a = *(const f32x4*)(sconv_w + 8 * cg + e), bq = *(const f32x4*)(sconv_w + 256 + 8 * cg + e), cq = *(const f32x4*)(sconv_w + 512 + 8 * cg + e);
#pragma unroll
          for (int k = 0; k < 4; ++k) { w0[e + k] = a[k]; w1[e + k] = bq[k]; w2[e + k] = cq[k]; } }
#pragma unroll
      for (int i = 0; i < 4; ++i) { const int t = pos + i; const float rc = 1.0f / (float)((t + 1) < win ? (t + 1) : win);
          float po[8], so[8];
#pragma unroll
          for (int e = 0; e < 8; ++e) { const unsigned cw = cur[i][e >> 1], ow = old[i][e >> 1], bw = sb[i][e >> 1], q0 = pp[i][e >> 1], q1 = pp[i + 1][e >> 1], q2 = pp[i + 2][e >> 1];
#define BFSEL(w) ((e & 1) ? __uint_as_float((w) & 0xffff0000u) : __uint_as_float((w) << 16))
              const float u = BFSEL(cw); s[e] += u; po[e] = s[e] * rc - u; s[e] -= BFSEL(ow);
              so[e] = BFSEL(bw) * (w0[e] * BFSEL(q0) + w1[e] * BFSEL(q1) + w2[e] * BFSEL(q2));
#undef BFSEL
          }
          v4u o1, o2; o1.x = pk2(po[0], po[1]); o1.y = pk2(po[2], po[3]); o1.z = pk2(po[4], po[5]); o1.w = pk2(po[6], po[7]);
          o2.x = pk2(so[0], so[1]); o2.y = pk2(so[2], so[3]); o2.z = pk2(so[4], so[5]); o2.w = pk2(so[6], so[7]);
          *(v4u*)(MIX + (row + i) * D + 8 * cg) = o1; *(v4u*)(MIX + (row + i) * D + 256 + 8 * cg) = o2; } }
    __syncthreads();
    { const int cp = tid & 127, tg = tid >> 7;
      float a0[16], a1[16]; const float b0 = cdw_b[2 * cp], b1 = cdw_b[2 * cp + 1];
#pragma unroll
      for (int i = 0; i < 16; ++i) { a0[i] = b0; a1[i] = b1; }
      float x0[46], x1[46];
#pragma unroll
      for (int r = 0; r < 46; ++r) { const unsigned u = Us[(16 * tg + r) * 128 + cp]; x0[r] = __uint_as_float(u << 16); x1[r] = __uint_as_float(u & 0xffff0000u); }
#pragma unroll
      for (int j = 0; j < 31; ++j) { typedef float f32x2v __attribute__((ext_vector_type(2))); const f32x2v w = *(const LAS f32x2v*)(Ws + j * 256 + 2 * cp);
#pragma unroll
          for (int i = 0; i < 16; ++i) { a0[i] += w.x * x0[i + j]; a1[i] += w.y * x1[i + j]; } }
#pragma unroll
      for (int i = 0; i < 16; ++i) { typedef float f32x2v __attribute__((ext_vector_type(2))); *(LAS f32x2v*)(Cs + (16 * tg + i) * 256 + 2 * cp) = (f32x2v){a0[i], a1[i]}; } }
    __syncthreads();
    { const f32x4 gg = *(const f32x4*)(cln_g + lane * 4), bb = *(const f32x4*)(cln_b + lane * 4);
#pragma unroll 1
      for (int k0 = 0; k0 < 8; k0 += 4) {
      f32x4 v[4]; float s[4];
#pragma unroll
      for (int k = 0; k < 4; ++k) { v[k] = *(const LAS f32x4*)(Cs + (wid * 8 + k0 + k) * 256 + lane * 4); s[k] = (v[k].x + v[k].y) + (v[k].z + v[k].w); }
#pragma unroll
      for (int o = 1; o < 64; o <<= 1)
#pragma unroll
          for (int k = 0; k < 4; ++k) s[k] += __shfl_xor(s[k], o);
#pragma unroll
      for (int k = 0; k < 4; ++k) { v[k] = v[k] - s[k] * (1.0f / 256.0f); s[k] = (v[k].x * v[k].x + v[k].y * v[k].y) + (v[k].z * v[k].z + v[k].w * v[k].w); }
#pragma unroll
      for (int o = 1; o < 64; o <<= 1)
#pragma unroll
          for (int k = 0; k < 4; ++k) s[k] += __shfl_xor(s[k], o);
#pragma unroll
      for (int k = 0; k < 4; ++k) { const float r = rsqrtf(s[k] * (1.0f / 256.0f) + EPS);
        float y[4];
#pragma unroll
        for (int e = 0; e < 4; ++e) { const float t = v[k][e] * r * gg[e] + bb[e]; y[e] = t * __builtin_amdgcn_rcpf(1.0f + __builtin_amdgcn_exp2f(-1.4426950408889634f * t)); }
        *(unsigned long long*)(MIX + (row0 + wid * 8 + k0 + k) * D + 512 + lane * 4) = (unsigned long long)pk2(y[0], y[1]) | ((unsigned long long)pk2(y[2], y[3]) << 32); } } }
    __syncthreads();
}

constexpr int P2_SCAL = 64 + 4 * 320;
__device__ __forceinline__ void p2_setup(Frame& F, const Args& A, int l) {
    int tid_ = mk_tid(F.wave); asm volatile("" : "+v"(tid_));
    const int tid = tid_, lane = tid & 63;
    LAS float* tab = (LAS float*)(F.lds + RING_OFF + att::TAB_OFF);
    const float* relb = A.in[I_RELB];
    if (tid < 64) tab[tid] = A.in[I_SUBG][l * 64 + tid];
    for (int i = tid; i < 4 * 320; i += NWAVES * 64) { const int h = i / 320, dist = 224 - (i % 320);
        tab[64 + i] = dist < 0 ? -1.0e30f : (relb[(int)REL_BUCKET_TAB[dist > 127 ? 127 : dist] * NH + h] - relb[31 * NH + h]) * att::LOG2E; }
    if (tid >= 448) {
        const int i = lane & 31; float s1 = A.in[I_LQ1][l * 32 + i] * A.in[I_LK1][l * 32 + i], s2 = A.in[I_LQ2][l * 32 + i] * A.in[I_LK2][l * 32 + i];
#pragma unroll
        for (int o = 1; o < 32; o <<= 1) { s1 += __shfl_xor(s1, o); s2 += __shfl_xor(s2, o); }
        const float lam_init = 0.8f - 0.6f * expf(-0.3f * (float)l);
        if (lane == 0) { tab[P2_SCAL] = expf(s1) - expf(s2) + lam_init; tab[P2_SCAL + 1] = 1.0f - lam_init; } }
    for (int i = tid; i < 31 * 64; i += NWAVES * 64) *(LAS f32x4*)(F.lds + RING_OFF + CONV_WS + i * 16) = *(const f32x4*)(A.in[I_CDWW] + (size_t)l * 31 * 256 + i * 4);
}
__device__ __forceinline__ void p2_fast(Frame& F, const Args& A, int l) {
    int tid_ = mk_tid(F.wave); asm volatile("" : "+v"(tid_));
    const int tid = tid_, lane = tid & 63, wid = __builtin_amdgcn_readfirstlane(tid >> 6);
    const unsigned char* Kimg = F.ws + WS_KIMG; const unsigned char* Vimg = F.ws + WS_VIMG; const bf16* Qn = (const bf16*)(F.ws + WS_QN);
    const float lam = ((const LAS float*)(F.lds + RING_OFF + att::TAB_OFF))[P2_SCAL], oml = ((const LAS float*)(F.lds + RING_OFF + att::TAB_OFF))[P2_SCAL + 1], negB = 0.f;
    for (int u = F.vcu; u < BATCH * NH * 8; u += F.G) {
        const int v = u & 255, bh = v >> 2, qb = u < 256 ? 7 - (v & 3) : (v & 3);
        att::attn_unit<0>(F.lds + RING_OFF, Qn, Kimg, Vimg, ((bf16*)(F.ws + WS_MIX)), A.in[I_RELB], A.in[I_SUBG] + l * 64, bh >> 2, bh & 3, qb, negB, lam, oml, tid, lane, wid);
    }
    for (int rep = 0; rep < A.conv_reps; ++rep)
    for (int k = 0; k < 2; ++k)
        conv_unit(F.lds + RING_OFF, ((bf16*)(F.ws + WS_ZC)), ((bf16*)(F.ws + WS_MIX)), A.in[I_SCONVW] + l * 3 * 256, A.in[I_CDWB] + l * 256, A.in[I_CLNG] + l * 256, A.in[I_CLNB] + l * 256, 2 * (F.vcu >> 5) + k, F.vcu & 31, tid, lane, wid);
}

constexpr int RSTAB_OFF = RING_BYTES;
__device__ __forceinline__ pg8::RstdSrc build_rstd(Frame& F, const pg8::StaticOrder& S, int& pmA, int& pmB) {
    pg8::Unit u; bool ok = true; pmA = -1; pmB = -1;
    for (int i = 0; S.next(i, u); ++i) { if (pmA < 0) pmA = u.pm; else if (u.pm != pmA) { if (pmB < 0) pmB = u.pm; else if (u.pm != pmB) ok = false; } }
    if (!ok && mk_tid(F.wave) == 0) __hip_atomic_store(F.ctl + CW_TMO, 0xBAD2u, RLX_AGENT);
    pg8::RstdSrc r; r.tab = (const LAS float*)(F.lds + RSTAB_OFF); r.pmA = pmA; return r;
}

__global__ void __launch_bounds__(NWAVES * 64, 2) fwd_kernel(Args args) {
    extern __shared__ __attribute__((aligned(16))) unsigned char lds[];
    Frame F;
    F.lds = (LAS unsigned char*)lds;
    F.MISC = (volatile LAS unsigned*)(F.lds + MISC_OFF);
    F.tid = threadIdx.x; F.lane = F.tid & 63; F.wave = __builtin_amdgcn_readfirstlane(F.tid >> 6);
    F.G = GRID_WG; { const int bx = blockIdx.x & (GRID_WG - 1);
      F.vcu = (F.G % 8 == 0) ? (bx % 8) * (F.G / 8) + bx / 8 : bx; }
    unsigned char* ws = args.ws; F.ws = ws;
    F.ctl = (gu32*)(ws + WS_CTL);
    for (int u = F.tid; u < (LDS_BYTES - LDSCTL_OFF) / 4; u += NWAVES * 64) ((LAS unsigned*)(F.lds + LDSCTL_OFF))[u] = 0u;
    __syncthreads();
    XcdBarrier bar; bar.bar = (unsigned*)(F.ctl + CW_BAR); bar.x = 0; bar.st = nullptr;
    if (!MK_PER_PHASE) { bar = xcd_barrier_post((unsigned*)(F.ctl + CW_BAR), F.MISC + 8); if (threadIdx.x == 0) (void)xb_add((unsigned*)F.ctl + GB_CEN(blockIdx.x & 7u, bar.x), 1u); }
    bar.wave = F.wave;
    const int lo = args.ph_lo, hi = args.ph_hi;
#define IN(k) (lo <= (k) && (k) < hi)
#define BOTH(k) (IN(k) && IN((k) + 1))
#define GROUP_BAR() do { if (MK_PER_PHASE) { if (F.tid == 0) __hip_atomic_store(F.ctl + CW_TMO, 0xBADBA0u, RLX_AGENT); } else { group_barrier((unsigned*)F.ctl, (unsigned*)(F.ctl + CW_BAR), F.MISC + 10, F.wave); } } while (0)
#define GRID_BAR() do { if (MK_PER_PHASE) { if (F.tid == 0) __hip_atomic_store(F.ctl + CW_TMO, 0xBADBA0u, RLX_AGENT); } else { xcd_barrier(bar); } } while (0)

    if (IN(0)) { p0_prologue(F, args);
        if (BOTH(0)) GRID_BAR(); }
    for (int l = 0; l < DEPTH; ++l) {
        const int p = 1 + 5 * l;
        if (IN(p)) {
            pg8::Gemm g{((bf16*)(F.ws + WS_XB)), w_ptr(F, l, WOFF_IN), M, DIN, D}; pg8::StaticOrder S; S.init(M, DIN, F.G, (int)(blockIdx.x & (GRID_WG - 1))); S.lim = 4 * F.G;
            int pmA, pmB; pg8::EpiIn E{F.ws, build_rstd(F, S, pmA, pmB), args.in[I_QNG] + l * 32, args.in[I_KNG] + l * 32};
            pg8::gemm_phase<pg8::EpiIn, pg8::StaticOrder, PG8_ALIGN, PG8_SP2, false, true>(F.lds + RING_OFF, g, S, E, F.wave, (const float*)(F.ws + WS_PART), (LAS float*)(F.lds + RSTAB_OFF), pmA, pmB);
            { pg8::TailOrder T{(int)(blockIdx.x & (GRID_WG - 1))}; pg8::EpiInTail ET{F.ws, args.in[I_KNG] + l * 32};
              pg8::gemm_phase<pg8::EpiInTail, pg8::TailOrder, PG8_ALIGN, PG8_SP2, true>(F.lds + RING_OFF, g, T, ET, F.wave); }
            if (BOTH(p)) { p2_setup(F, args, l); GROUP_BAR(); }
        }
        if (IN(p + 1)) {
            if (!IN(p)) { p2_setup(F, args, l); __syncthreads(); }
            p2_fast(F, args, l);
            if (BOTH(p + 1)) GROUP_BAR();
        }
#pragma nounroll
        for (int s3 = 0; s3 < 3; ++s3) {
            const int ph = p + 2 + s3;
            if (!IN(ph)) continue;
            if (s3 == 1) {
                pg8::Gemm g{((bf16*)(F.ws + WS_XB)), w_ptr(F, l, WOFF_GU), M, NGU, D}; pg8::StaticOrder S; S.init(M, NGU, F.G, (int)(blockIdx.x & (GRID_WG - 1)));
                int pmA, pmB; pg8::EpiGLU E{((bf16*)(F.ws + WS_ACT)), DFF, build_rstd(F, S, pmA, pmB)};
                pg8::gemm_phase<pg8::EpiGLU, pg8::StaticOrder, PG8_ALIGN, PG8_SP2, false, true>(F.lds + RING_OFF, g, S, E, F.wave, (const float*)(F.ws + WS_PART), (LAS float*)(F.lds + RSTAB_OFF), pmA, pmB);
            } else {
                const bool dn = s3 == 2;
                pg8::Gemm g{(bf16*)(F.ws + (dn ? WS_ACT : WS_MIX)), w_ptr(F, l, dn ? WOFF_DN : WOFF_OUT), M, D, dn ? DFF : D}; pg8::StaticOrder S; S.init(M, D, F.G, (int)(blockIdx.x & (GRID_WG - 1))); S.rev = 1;
                pg8::EpiRes E{F.ws, (dn && l == DEPTH - 1) ? args.out : nullptr};
                pg8::gemm_phase<pg8::EpiRes, pg8::StaticOrder, PG8_ALIGN, PG8_SP2>(F.lds + RING_OFF, g, S, E, F.wave);
            }
            if (BOTH(ph)) GROUP_BAR();
        }
    }
#undef IN
#undef BOTH
}

extern "C" void kernel_launch(void* const* d_in, const int* in_sizes, int n_in, void* d_out, int out_size, void* d_ws, size_t ws_size, hipStream_t stream) {
    static int grid = 0;
    if (grid == 0) {
        if (n_in != N_IN || in_sizes[0] != M * D || out_size != M * D || ws_size < WS_END) {
            fprintf(stderr, "kernel_launch: built for %d inputs, x/out of %d floats, >= %zu bytes of workspace; got n_in %d, in0 %d, out %d, ws %zu; nothing launched\n", N_IN, M * D, (size_t)WS_END, n_in, n_in > 0 ? in_sizes[0] : -1, out_size, ws_size);
            grid = -1; return; }
        int dev = 0, cus = 0, per_cu = 0;
        if (hipGetDevice(&dev) != hipSuccess || hipDeviceGetAttribute(&cus, hipDeviceAttributeMultiprocessorCount, dev) != hipSuccess) { fprintf(stderr, "kernel_launch: device query failed\n"); grid = -1; return; }
        if (hipFuncSetAttribute((const void*)fwd_kernel, hipFuncAttributeMaxDynamicSharedMemorySize, LDS_BYTES) != hipSuccess) { fprintf(stderr, "kernel_launch: hipFuncSetAttribute failed\n"); grid = -1; return; }
        if (hipOccupancyMaxActiveBlocksPerMultiprocessor(&per_cu, (const void*)fwd_kernel, NWAVES * 64, LDS_BYTES) != hipSuccess || per_cu < 1) {
            fprintf(stderr, "kernel_launch: occupancy query reports %d workgroups per CU; nothing launched\n", per_cu); (void)hipGetLastError(); grid = -1; return; }
        if (cus < 256) { fprintf(stderr, "kernel_launch: built for a 256-CU device (got %d CUs); nothing launched\n", cus); grid = -1; return; }
        grid = GRID_WG;
    }
    if (grid < 0) return;
    if (hipMemsetAsync((char*)d_ws + WS_CTL, 0, CTL_ZERO_BYTES, stream) != hipSuccess) { fprintf(stderr, "kernel_launch: memset failed\n"); return; }
    Args a{};
    for (int i = 0; i < N_IN; ++i) a.in[i] = (const float*)d_in[i];
    a.out = (float*)d_out; a.ws = (unsigned char*)d_ws;
    a.att_reps = 1; a.conv_reps = 1;
#if MK_PER_PHASE
    for (int p = 0; p < NPH; ++p) { a.ph_lo = p; a.ph_hi = p + 1; hipLaunchKernelGGL(fwd_kernel, dim3(grid), dim3(NWAVES * 64), LDS_BYTES, stream, a); }
#else
    a.ph_lo = 0; a.ph_hi = NPH;
    hipLaunchKernelGGL(fwd_kernel, dim3(grid), dim3(NWAVES * 64), LDS_BYTES, stream, a);
#endif
    const hipError_t le = hipPeekAtLastError();
    if (le != hipSuccess) fprintf(stderr, "kernel_launch: launch failed: %s\n", hipGetErrorName(le));
}
```

```cpp
#include <hip/hip_runtime.h>
#include <cstdio>
#include <cstdint>
#define MK_PER_PHASE 0
#ifndef PG8_SP2
#define PG8_SP2 true
#endif
#ifndef PG8_ALIGN
#define PG8_ALIGN true
#endif
#ifndef MK_PER_PHASE
#define MK_PER_PHASE 0
#endif
constexpr int NWAVES = 8;
constexpr int GRID_WG = 256;
constexpr int BATCH = 16, SEQ = 2048, D = 1024, DEPTH = 2, M = BATCH * SEQ;
constexpr int DIN = 2304, DFF = 2816, NGU = 2 * DFF;
constexpr int NH = 4;
constexpr float EPS = 1e-6f;
constexpr int NPH = 1 + 5 * DEPTH;
enum { I_X = 0, I_N1G, I_WIN, I_POOLW, I_POOLS, I_SCONVW, I_CDWW, I_CDWB, I_CLNG, I_CLNB, I_QNG, I_KNG, I_LQ1, I_LK1, I_LQ2, I_LK2, I_SUBG, I_WOUT, I_N2G, I_WGATE, I_WUP, I_WDOWN, I_RELB, N_IN };
constexpr size_t MiB = 1u << 20;
constexpr size_t WS_CTL = 0, CTL_ZERO_BYTES = 32768;
constexpr size_t WS_PART = 1 * MiB;
constexpr size_t WS_W = 4 * MiB, W_LAYER = 23 * MiB;
constexpr size_t WOFF_IN = 0, WOFF_OUT = (size_t)DIN * D * 2, WOFF_GU = WOFF_OUT + (size_t)D * D * 2, WOFF_DN = WOFF_GU + (size_t)NGU * D * 2;
static_assert(WOFF_DN + (size_t)D * DFF * 2 <= W_LAYER, "weight map");
constexpr size_t WS_XB = WS_W + DEPTH * W_LAYER;
constexpr size_t WS_ZC = WS_XB + (size_t)M * D * 2;
constexpr size_t WS_QN = WS_ZC + (size_t)M * D * 2;
constexpr size_t WS_KIMG = WS_QN + (size_t)M * 256 * 2;
constexpr size_t WS_VIMG = WS_KIMG + (size_t)M * 256 * 2;
constexpr size_t WS_MIX = WS_VIMG + (size_t)M * 256 * 2;
constexpr size_t WS_ACT = WS_MIX + (size_t)M * D * 2;
constexpr size_t WS_END = WS_ACT + (size_t)M * DFF * 2;
static_assert(WS_ACT + (size_t)M * DFF * 2 <= WS_END, "ACT overlay");
constexpr int CW_TMO = 0, CW_CODE = 1;
constexpr int CW_BAR = 4096;
constexpr int RING_OFF = 0, RING_BYTES = 131072;
constexpr int PHASE_LDS = 162816;
constexpr int LDSCTL_OFF = PHASE_LDS, MISC_OFF = LDSCTL_OFF + 320;
constexpr int LDS_BYTES = 163840;
static_assert(MISC_OFF + 128 <= LDS_BYTES, "LDS map");


__device__ __forceinline__ int mk_lane() { int l; asm volatile("v_mbcnt_lo_u32_b32 %0, -1, 0\n\tv_mbcnt_hi_u32_b32 %0, -1, %0" : "=v"(l)); return l; }
__device__ __forceinline__ int mk_tid(int wave) { return wave * 64 + mk_lane(); }
template <int CTRL> __device__ __forceinline__ float dpp_f(float x) { return __builtin_bit_cast(float, __builtin_amdgcn_mov_dpp(__builtin_bit_cast(int, x), CTRL, 0xf, 0xf, true)); }
__device__ __forceinline__ float xrow16_sum(float x) {
    auto s = __builtin_amdgcn_permlane16_swap(__float_as_uint(x), __float_as_uint(x), false, false);
    x = __uint_as_float(s[0]) + __uint_as_float(s[1]);
    auto t = __builtin_amdgcn_permlane32_swap(__float_as_uint(x), __float_as_uint(x), false, false);
    return __uint_as_float(t[0]) + __uint_as_float(t[1]);
}
__device__ __forceinline__ float wave_sum_fast(float x) {
    x += dpp_f<0xB1>(x); x += dpp_f<0x4E>(x); x += dpp_f<0x141>(x); x += dpp_f<0x128>(x);
    return xrow16_sum(x);
}
namespace pg8 {
#define PG8_LAS __attribute__((address_space(3)))
typedef unsigned short bf16_t;
typedef short bf16x8 __attribute__((ext_vector_type(8)));
typedef float f32x4 __attribute__((ext_vector_type(4)));
typedef unsigned u32x4 __attribute__((ext_vector_type(4)));
constexpr int BM = 256, BK = 64, HALF = 128, HTB = HALF * BK * 2  , STAGE_BYTES = 8 * HTB, NXCD = 8, WGM = 8;

__host__ __device__ __forceinline__ int lds_byte(int r, int c) { const int st = (r >> 4) * 2 + (c >> 5), rr = r & 15, cc = c & 31, ob = rr * 64 + cc * 2; return st * 1024 + (ob ^ (((ob >> 9) & 1) << 5)); }
__host__ __device__ __forceinline__ void stage_rc(int b, int& R, int& C) { const int st = b / 1024, sb = b % 1024, swz = sb ^ (((sb >> 9) & 1) << 5); R = (st >> 1) * 16 + swz / 64; C = (st & 1) * 32 + (swz % 64) / 2; }
__host__ __device__ __forceinline__ int perm32(int rho) { const int n = rho >> 4, i = rho & 15; return 8 * (i >> 2) + 4 * n + (i & 3); }

struct Unit { int pm, pn, hn; };
struct Gemm { const bf16_t* A; const bf16_t* Bt; int M, N, K; };

struct StaticOrder {
    int nM, nN, nwg, G, c, lim, rev = 0;
    __host__ __device__ void init(int M, int N, int G_, int c_) { nM = M / BM; nN = N / BM; nwg = nM * nN; G = G_; c = c_; lim = nwg; }
    __host__ __device__ bool next(int i, Unit& u) const {
        const long L = (long)i * G + c; if (L >= lim) return false; u.hn = 0;
        int wgid = (int)L; { const int q = nwg / NXCD, r = nwg % NXCD, xcd = wgid % NXCD; int off = wgid / NXCD; if (rev) off = (q + (xcd < r ? 1 : 0)) - 1 - off; wgid = (xcd < r ? xcd * (q + 1) : r * (q + 1) + (xcd - r) * q) + off; }
        const int nig = WGM * nN, gid = wgid / nig, fm = gid * WGM, gsz = (nM - fm) < WGM ? (nM - fm) : WGM;
        u.pm = fm + ((wgid % nig) % gsz); u.pn = (wgid % nig) / gsz; return true;
    }
    __device__ __forceinline__ void a_ready(const Unit&) const {}
    __device__ __forceinline__ void done(const Unit&) const {}
};

struct TailOrder {
    int c;
    __host__ __device__ bool next(int i, Unit& u) const {
        if (i != 0) return false;
        const int xcd = c % NXCD, j = c / NXCD, w = 128 + (j >> 1);
        u.pm = (2 * xcd + 1) * WGM + ((w - 72) % WGM); u.pn = (w - 72) / WGM; u.hn = j & 1; return true;
    }
    __device__ __forceinline__ void a_ready(const Unit&) const {}
    __device__ __forceinline__ void done(const Unit&) const {}
};

typedef float f32x2c_t __attribute__((ext_vector_type(2))); typedef __bf16 bf16x2c_t __attribute__((ext_vector_type(2)));
__device__ __forceinline__ unsigned cvt_pk_bf16(float lo, float hi) { const f32x2c_t v = {lo, hi}; return __builtin_bit_cast(unsigned, __builtin_convertvector(v, bf16x2c_t)); }
typedef float f32x2 __attribute__((ext_vector_type(2)));

__device__ __forceinline__ float row_rstd(const float* part, int row, int fq) {
    const f32x4 p = *(const f32x4*)(part + (size_t)row * 16 + 4 * fq);
    float s = (p[0] + p[1]) + (p[2] + p[3]);
    s = xrow16_sum(s);
    return rsqrtf(s * (1.0f / 1024.0f) + 1e-6f);
}
struct RstdSrc {
    const PG8_LAS float* tab; int pmA;
    __device__ __forceinline__ float get(int pm, int rl  , int fq) const { return tab[(pm == pmA ? 0 : 256) + rl]; }
};
__device__ __forceinline__ float silu_f(float g) { return g * __builtin_amdgcn_rcpf(1.0f + __builtin_amdgcn_exp2f(-1.4426950408889634f * g)); }

struct EpiGLU {
    static constexpr bool PERM = true, AFTER_DRAIN = false; static constexpr int MIN_STORES = 8;
    bf16_t* O; int ldc; RstdSrc rsrc;
    __device__ __forceinline__ void operator()(const f32x4 (&acc)[2][2][4][2], const Unit& u, int wr, int wc, int fr, int fq) const {
        const int row0 = u.pm * BM + wr * 64 + fr, col0 = u.pn * HALF + wc * 32 + 8 * fq;
#pragma unroll
        for (int ai = 0; ai < 2; ++ai)
#pragma unroll
            for (int m = 0; m < 4; ++m) {
                const int row = row0 + ai * HALF + m * 16;
                const float rs = rsrc.get(u.pm, ai * HALF + wr * 64 + m * 16 + fr, fq);
                const float c1 = -1.4426950408889634f * rs, rs2 = rs * rs;
                f32x4 o[2];
#pragma unroll
                for (int n = 0; n < 2; ++n) { const f32x4 g = acc[ai][0][m][n], uu = acc[ai][1][m][n]; f32x4 e = g * c1;
#pragma unroll
                    for (int i = 0; i < 4; ++i) e[i] = __builtin_amdgcn_exp2f(e[i]);
                    e = e + 1.0f;
#pragma unroll
                    for (int i = 0; i < 4; ++i) e[i] = __builtin_amdgcn_rcpf(e[i]);
                    o[n] = (g * uu) * (e * rs2); }
                u32x4 w; w.x = cvt_pk_bf16(o[0][0], o[0][1]); w.y = cvt_pk_bf16(o[0][2], o[0][3]); w.z = cvt_pk_bf16(o[1][0], o[1][1]); w.w = cvt_pk_bf16(o[1][2], o[1][3]);
                *(u32x4*)(O + (size_t)row * ldc + col0) = w;
            }
    }
};
struct EpiRes {
    static constexpr bool PERM = true, AFTER_DRAIN = false; static constexpr int MIN_STORES = 24;
    unsigned char* ws; float* outf;
    __device__ __forceinline__ void operator()(const f32x4 (&acc)[2][2][4][2], const Unit& u, int wr, int wc, int fr, int fq) const {
        const int row0 = u.pm * BM + wr * 64 + fr, col0 = u.pn * BM + wc * 32 + 8 * fq;
        bf16_t* const xb = (bf16_t*)(ws + WS_XB); float* const part = (float*)(ws + WS_PART);
        u32x4 bw[2][4][2];
#pragma unroll
        for (int ai = 0; ai < 2; ++ai)
#pragma unroll
            for (int m = 0; m < 4; ++m)
#pragma unroll
                for (int bj = 0; bj < 2; ++bj) bw[ai][m][bj] = *(const u32x4*)(xb + (size_t)(row0 + ai * HALF + m * 16) * 1024 + col0 + bj * HALF);
        __builtin_amdgcn_sched_barrier(0);
#pragma unroll
        for (int ai = 0; ai < 2; ++ai)
#pragma unroll
            for (int m = 0; m < 4; ++m) {
                const int row = row0 + ai * HALF + m * 16; const size_t off = (size_t)row * 1024 + col0;
                float ss = 0.f;
#pragma unroll
                for (int bj = 0; bj < 2; ++bj) {
                    const u32x4 b = bw[ai][m][bj];
                    const f32x4 b0 = {__uint_as_float(b.x << 16), __uint_as_float(b.x & 0xffff0000u), __uint_as_float(b.y << 16), __uint_as_float(b.y & 0xffff0000u)};
                    const f32x4 b1 = {__uint_as_float(b.z << 16), __uint_as_float(b.z & 0xffff0000u), __uint_as_float(b.w << 16), __uint_as_float(b.w & 0xffff0000u)};
                    const f32x4 o0 = b0 + acc[ai][bj][m][0], o1 = b1 + acc[ai][bj][m][1];
                    if (outf) { __builtin_nontemporal_store(o0, (f32x4*)(outf + off + bj * HALF)); __builtin_nontemporal_store(o1, (f32x4*)(outf + off + bj * HALF + 4)); }
                    else { u32x4 w; w.x = cvt_pk_bf16(o0[0], o0[1]); w.y = cvt_pk_bf16(o0[2], o0[3]); w.z = cvt_pk_bf16(o1[0], o1[1]); w.w = cvt_pk_bf16(o1[2], o1[3]);
                        *(u32x4*)(xb + off + bj * HALF) = w; }
                    ss += ((o0[0] * o0[0] + o0[1] * o0[1]) + (o0[2] * o0[2] + o0[3] * o0[3])) + ((o1[0] * o1[0] + o1[1] * o1[1]) + (o1[2] * o1[2] + o1[3] * o1[3]));
                }
                ss = xrow16_sum(ss);
                if (fq == 0) part[(size_t)row * 16 + u.pn * 4 + wc] = ss;
            }
    }
};


constexpr float QSCALE_LOG2E = 0.17677669529663687f * 1.4426950408889634f;
struct EpiIn {
    static constexpr bool PERM = true, AFTER_DRAIN = false; static constexpr int MIN_STORES = 8;
    unsigned char* ws; RstdSrc rsrc; const float* qg; const float* kg;
    __device__ __forceinline__ void operator()(const f32x4 (&acc)[2][2][4][2], const Unit& u, int wr, int wc, int fr, int fq) const {
        const int row0 = u.pm * BM + wr * 64 + fr, pn = u.pn, c8 = wc * 32 + 8 * fq;
        bf16_t* const ZC = (bf16_t*)(ws + WS_ZC); bf16_t* const Qn = (bf16_t*)(ws + WS_QN); unsigned char* const Kimg = ws + WS_KIMG; unsigned char* const Vimg = ws + WS_VIMG;
        if (pn < 2) {
#pragma unroll
            for (int ai = 0; ai < 2; ++ai)
#pragma unroll
                for (int m = 0; m < 4; ++m) {
                    const int row = row0 + ai * HALF + m * 16; const float rs = rsrc.get(u.pm, ai * HALF + wr * 64 + m * 16 + fr, fq);
                    bf16_t* rowp = ZC + (size_t)row * 1024 + pn * 256 + c8;
#pragma unroll
                    for (int bj = 0; bj < 2; ++bj) {
                        const f32x4 v0 = acc[ai][bj][m][0] * rs, v1 = acc[ai][bj][m][1] * rs;
                        u32x4 w; w.x = cvt_pk_bf16(v0[0], v0[1]); w.y = cvt_pk_bf16(v0[2], v0[3]); w.z = cvt_pk_bf16(v1[0], v1[1]); w.w = cvt_pk_bf16(v1[2], v1[3]);
                        *(u32x4*)(rowp + bj * HALF) = w;
                    }
                }
        } else if (pn < 6) {
            const bool glu = pn >= 4; const int dcol = 512 + (glu ? 256 : 0) + ((pn - 2) & 1) * 128 + c8;
#pragma unroll
            for (int ai = 0; ai < 2; ++ai)
#pragma unroll
                for (int m = 0; m < 4; ++m) {
                    const int row = row0 + ai * HALF + m * 16; const float rs = rsrc.get(u.pm, ai * HALF + wr * 64 + m * 16 + fr, fq);
                    f32x4 o[2];
                    if (glu) { const float c1 = -1.4426950408889634f * rs;
#pragma unroll
                        for (int n = 0; n < 2; ++n) { f32x4 e = acc[ai][1][m][n] * c1;
#pragma unroll
                            for (int i = 0; i < 4; ++i) e[i] = __builtin_amdgcn_exp2f(e[i]);
                            e = e + 1.0f;
#pragma unroll
                            for (int i = 0; i < 4; ++i) e[i] = __builtin_amdgcn_rcpf(e[i]);
                            o[n] = (acc[ai][0][m][n] * rs) * e; } }
                    else { const float rs2 = rs * rs;
#pragma unroll
                        for (int n = 0; n < 2; ++n) o[n] = (acc[ai][0][m][n] * acc[ai][1][m][n]) * rs2; }
                    u32x4 w; w.x = cvt_pk_bf16(o[0][0], o[0][1]); w.y = cvt_pk_bf16(o[0][2], o[0][3]); w.z = cvt_pk_bf16(o[1][0], o[1][1]); w.w = cvt_pk_bf16(o[1][2], o[1][3]);
                    *(u32x4*)(ZC + (size_t)row * 1024 + dcol) = w;
                }
        } else if (pn < 8) {
            const float* gp = (pn == 6 ? qg : kg) + 8 * fq; const f32x4 g0 = *(const f32x4*)gp, g1 = *(const f32x4*)(gp + 4);
            const float osc = pn == 6 ? QSCALE_LOG2E : 1.0f;
#pragma unroll
            for (int ai = 0; ai < 2; ++ai)
#pragma unroll
                for (int m = 0; m < 4; ++m) {
                    const int row = row0 + ai * HALF + m * 16; const float rs = rsrc.get(u.pm, ai * HALF + wr * 64 + m * 16 + fr, fq);
#pragma unroll
                    for (int bj = 0; bj < 2; ++bj) {
                        const f32x4 v0 = acc[ai][bj][m][0] * rs, v1 = acc[ai][bj][m][1] * rs;
                        float ss = ((v0[0] * v0[0] + v0[1] * v0[1]) + (v0[2] * v0[2] + v0[3] * v0[3])) + ((v1[0] * v1[0] + v1[1] * v1[1]) + (v1[2] * v1[2] + v1[3] * v1[3]));
                        ss = xrow16_sum(ss);
                        const float rn = rsqrtf(ss * (1.0f / 32.0f) + 1e-6f) * osc;
                        const f32x4 o0 = v0 * rn * g0, o1 = v1 * rn * g1;
                        u32x4 w; w.x = cvt_pk_bf16(o0[0], o0[1]); w.y = cvt_pk_bf16(o0[2], o0[3]); w.z = cvt_pk_bf16(o1[0], o1[1]); w.w = cvt_pk_bf16(o1[2], o1[3]);
                        if (pn == 6) *(u32x4*)(Qn + (size_t)row * 256 + bj * HALF + c8) = w;
                        else { const int hm = 4 * bj + wc, b = row >> 11, t = row & 2047, kv = t & 63;
                            unsigned char* p = Kimg + ((size_t)((b * 4 + (hm >> 1)) * 32 + (t >> 6)) << 13) + kv * 128 + ((((hm & 1) * 4 + fq) ^ ((kv >> 1) & 7)) << 4);
                            *(u32x4*)p = w; }
                    }
                }
        } else {
#pragma unroll
            for (int ai = 0; ai < 2; ++ai)
#pragma unroll
                for (int m = 0; m < 4; ++m) {
                    const int row = row0 + ai * HALF + m * 16; const float rs = rsrc.get(u.pm, ai * HALF + wr * 64 + m * 16 + fr, fq);
                    const int b = row >> 11, t = row & 2047, kv = t & 63;
#pragma unroll
                    for (int bj = 0; bj < 2; ++bj) {
                        const f32x4 v0 = acc[ai][bj][m][0] * rs, v1 = acc[ai][bj][m][1] * rs;
                        u32x4 w; w.x = cvt_pk_bf16(v0[0], v0[1]); w.y = cvt_pk_bf16(v0[2], v0[3]); w.z = cvt_pk_bf16(v1[0], v1[1]); w.w = cvt_pk_bf16(v1[2], v1[3]);
                        unsigned char* p = Vimg + ((size_t)((b * 4 + 2 * bj + (wc >> 1)) * 32 + (t >> 6)) << 13) + 1024 * (kv >> 3) + 512 * (wc & 1) + 64 * (kv & 7) + 16 * fq;
                        *(u32x4*)p = w;
                    }
                }
        }
    }
};
struct EpiInTail {
    static constexpr bool PERM = true, AFTER_DRAIN = false; static constexpr int MIN_STORES = 0;
    unsigned char* ws; const float* kg;
    __device__ __forceinline__ void operator()(const f32x4 (&acc)[2][2][4][2], const Unit& u, int wr, int wc, int fr, int fq) const {
        const int row0 = u.pm * BM + wr * 64 + fr, bj = u.hn;
        unsigned char* const Kimg = ws + WS_KIMG; unsigned char* const Vimg = ws + WS_VIMG; const float* const part = (const float*)(ws + WS_PART);
        float rsv[2][4];
#pragma unroll
        for (int ai = 0; ai < 2; ++ai)
#pragma unroll
            for (int m = 0; m < 4; ++m) rsv[ai][m] = row_rstd(part, row0 + ai * HALF + m * 16, fq);
        if (u.pn == 7) {
            const float* gp = kg + 8 * fq; const f32x4 g0 = *(const f32x4*)gp, g1 = *(const f32x4*)(gp + 4);
#pragma unroll
            for (int ai = 0; ai < 2; ++ai)
#pragma unroll
                for (int m = 0; m < 4; ++m) {
                    const int row = row0 + ai * HALF + m * 16; const float rs = rsv[ai][m];
                    const f32x4 v0 = acc[ai][0][m][0] * rs, v1 = acc[ai][0][m][1] * rs;
                    float ss = ((v0[0] * v0[0] + v0[1] * v0[1]) + (v0[2] * v0[2] + v0[3] * v0[3])) + ((v1[0] * v1[0] + v1[1] * v1[1]) + (v1[2] * v1[2] + v1[3] * v1[3]));
                    ss = xrow16_sum(ss);
                    const float rn = rsqrtf(ss * (1.0f / 32.0f) + 1e-6f);
                    const f32x4 o0 = v0 * rn * g0, o1 = v1 * rn * g1;
                    u32x4 w; w.x = cvt_pk_bf16(o0[0], o0[1]); w.y = cvt_pk_bf16(o0[2], o0[3]); w.z = cvt_pk_bf16(o1[0], o1[1]); w.w = cvt_pk_bf16(o1[2], o1[3]);
                    const int hm = 4 * bj + wc, b = row >> 11, t = row & 2047, kv = t & 63;
                    unsigned char* p = Kimg + ((size_t)((b * 4 + (hm >> 1)) * 32 + (t >> 6)) << 13) + kv * 128 + ((((hm & 1) * 4 + fq) ^ ((kv >> 1) & 7)) << 4);
                    *(u32x4*)p = w;
                }
        } else {
#pragma unroll
            for (int ai = 0; ai < 2; ++ai)
#pragma unroll
                for (int m = 0; m < 4; ++m) {
                    const int row = row0 + ai * HALF + m * 16; const float rs = rsv[ai][m];
                    const int b = row >> 11, t = row & 2047, kv = t & 63;
                    const f32x4 v0 = acc[ai][0][m][0] * rs, v1 = acc[ai][0][m][1] * rs;
                    u32x4 w; w.x = cvt_pk_bf16(v0[0], v0[1]); w.y = cvt_pk_bf16(v0[2], v0[3]); w.z = cvt_pk_bf16(v1[0], v1[1]); w.w = cvt_pk_bf16(v1[2], v1[3]);
                    unsigned char* p = Vimg + ((size_t)((b * 4 + 2 * bj + (wc >> 1)) * 32 + (t >> 6)) << 13) + 1024 * (kv >> 3) + 512 * (wc & 1) + 64 * (kv & 7) + 16 * fq;
                    *(u32x4*)p = w;
                }
        }
    }
};
template <class Epi, class Sched, bool ALIGN_EPI = false, bool SP2 = false, bool HN = false, bool RS = false>
__device__ __forceinline__ void gemm_phase(PG8_LAS unsigned char* lds, const Gemm g, const Sched& S, const Epi& E, int wave_in, const float* rs_part = nullptr, PG8_LAS float* rs_tab = nullptr, int rs_pmA = -1, int rs_pmB = -1) {
    int tid_ = mk_tid(wave_in); asm volatile("" : "+v"(tid_));
    const int tid = tid_, wid = __builtin_amdgcn_readfirstlane(tid >> 6), lane = tid & 63, wr = wid >> 2, wc = wid & 3, fr = lane & 15, fq = lane >> 4;
    const int K = g.K, nt = K / BK;
    unsigned voffA[2], voffB[2];
#pragma unroll
    for (int i = 0; i < 2; ++i) { int R, C; stage_rc(tid * 16 + i * 8192, R, C); const int Rb = Epi::PERM ? ((R & ~31) + perm32(R & 31)) : R;
        voffA[i] = (unsigned)(R * K + C) * 2u; voffB[i] = (unsigned)(Rb * K + C) * 2u; }
    const size_t kstep = (size_t)(BK * 2);
    const size_t hstep = (size_t)HALF * K * 2;
    const size_t tstep = 2 * hstep;
    const unsigned ldsw = (unsigned)wid * 1024u;
    const int aoff = lds_byte(wr * 64 + fr, fq * 8), boff = lds_byte(wc * 32 + fr, fq * 8);
#define PG8_SA(b, h) (((b) * 2 + (h)) * HTB)
#define PG8_SB(b, h) ((4 + (b) * 2 + (h)) * HTB)
#define PG8_STAGE(bufoff, gbase, voff) do { _Pragma("unroll") for (int _i = 0; _i < 2; ++_i) \
        __builtin_amdgcn_global_load_lds((const unsigned*)((const char*)(gbase) + (voff)[_i]), (PG8_LAS unsigned*)(lds + (bufoff) + ldsw + _i * 8192), 16, 0, 0); } while (0)
#define PG8_LDA(dst, b, h) do { _Pragma("unroll") for (int m = 0; m < 4; ++m) _Pragma("unroll") for (int k = 0; k < 2; ++k) dst[m][k] = *(const PG8_LAS bf16x8*)(lds + PG8_SA(b, h) + aoff + m * 2048 + k * 1024); } while (0)
#define PG8_LDB(dst, b, h) do { _Pragma("unroll") for (int n = 0; n < 2; ++n) _Pragma("unroll") for (int k = 0; k < 2; ++k) dst[n][k] = *(const PG8_LAS bf16x8*)(lds + PG8_SB(b, h) + boff + n * 2048 + k * 1024); } while (0)
#define PG8_MMA(ai, bj, At, Bt) do { __builtin_amdgcn_s_setprio(1); _Pragma("unroll") for (int m = 0; m < 4; ++m) _Pragma("unroll") for (int n = 0; n < 2; ++n) _Pragma("unroll") for (int k = 0; k < 2; ++k) \
        acc[ai][bj][m][n] = __builtin_amdgcn_mfma_f32_16x16x32_bf16(Bt[n][k], At[m][k], acc[ai][bj][m][n], 0, 0, 0); __builtin_amdgcn_s_setprio(0); } while (0)
#define PG8_WAIT_V(n) asm volatile("s_waitcnt vmcnt(" #n ")" ::: "memory")
#define PG8_WAIT_V8_RELAX(f) do { if constexpr (Epi::MIN_STORES >= 24) asm volatile("s_waitcnt vmcnt(32)\n\ts_cmp_lg_u32 %0, 0\n\ts_cbranch_scc1 .Lpg8w_%=\n\ts_waitcnt vmcnt(8)\n.Lpg8w_%=:" :: "s"(f) : "memory", "scc"); \
        else asm volatile("s_waitcnt vmcnt(16)\n\ts_cmp_lg_u32 %0, 0\n\ts_cbranch_scc1 .Lpg8w_%=\n\ts_waitcnt vmcnt(8)\n.Lpg8w_%=:" :: "s"(f) : "memory", "scc"); } while (0)
#define PG8_WAIT_L(n) asm volatile("s_waitcnt lgkmcnt(" #n ")" ::: "memory")
#define PG8_BAR __builtin_amdgcn_s_barrier()
#define PG8_SCHED __builtin_amdgcn_sched_barrier(0)
    Unit cur, nxt; int ui = 0;
    if (!S.next(0, cur)) return;
    f32x4 rsq[4]; const int rs_pm = tid < 256 ? rs_pmA : rs_pmB;
    if constexpr (RS) { if (rs_pm >= 0) { const f32x4* p = (const f32x4*)(rs_part + ((size_t)rs_pm * 256 + (tid & 255)) * 16); rsq[0] = p[0]; rsq[1] = p[1]; rsq[2] = p[2]; rsq[3] = p[3]; } }
    f32x4 acc[2][2][4][2];
#pragma unroll
    for (int a = 0; a < 2; ++a)
#pragma unroll
        for (int b = 0; b < 2; ++b)
#pragma unroll
            for (int m = 0; m < 4; ++m)
#pragma unroll
                for (int n = 0; n < 2; ++n) acc[a][b][m][n] = (f32x4){0.f, 0.f, 0.f, 0.f};
    bf16x8 At[4][2], B0[2][2], B1[2][2];
    const char* cA = (const char*)g.A + (size_t)cur.pm * tstep; const char* cB = (const char*)g.Bt + (size_t)cur.pn * tstep + (HN ? (size_t)cur.hn * hstep : (size_t)0);
    S.a_ready(cur);
    if constexpr (HN) {
        PG8_STAGE(PG8_SB(0, 0), cB, voffB); PG8_STAGE(PG8_SA(0, 0), cA, voffA); PG8_STAGE(PG8_SA(0, 1), cA + hstep, voffA);
        if (wr == 1) PG8_BAR;
        PG8_WAIT_V(2); PG8_BAR;
        PG8_STAGE(PG8_SB(1, 0), cB + kstep, voffB); PG8_STAGE(PG8_SA(1, 0), cA + kstep, voffA);
        PG8_WAIT_V(4); PG8_BAR;
    } else if constexpr (SP2) {
        PG8_STAGE(PG8_SB(0, 0), cB, voffB); PG8_STAGE(PG8_SB(0, 1), cB + hstep, voffB); PG8_STAGE(PG8_SA(0, 0), cA, voffA); PG8_STAGE(PG8_SA(0, 1), cA + hstep, voffA);
        if (wr == 1) PG8_BAR;
        PG8_WAIT_V(2);
        if constexpr (RS) { if (rs_pm >= 0) { const f32x4 a = rsq[0], b = rsq[1], c = rsq[2], d = rsq[3];
            const float sq = (((a[0] + a[1]) + (a[2] + a[3])) + ((b[0] + b[1]) + (b[2] + b[3]))) + (((c[0] + c[1]) + (c[2] + c[3])) + ((d[0] + d[1]) + (d[2] + d[3])));
            rs_tab[tid] = rsqrtf(sq * (1.0f / 1024.0f) + 1e-6f); } }
        PG8_BAR;
        PG8_STAGE(PG8_SB(1, 0), cB + kstep, voffB); PG8_STAGE(PG8_SA(1, 0), cA + kstep, voffA); PG8_STAGE(PG8_SB(1, 1), cB + hstep + kstep, voffB);
        PG8_WAIT_V(6); PG8_BAR;
    } else {
        PG8_STAGE(PG8_SB(0, 0), cB, voffB); PG8_STAGE(PG8_SA(0, 0), cA, voffA); PG8_STAGE(PG8_SB(0, 1), cB + hstep, voffB); PG8_STAGE(PG8_SA(0, 1), cA + hstep, voffA);
        if (wr == 1) PG8_BAR;
        PG8_WAIT_V(4); PG8_BAR;
        PG8_STAGE(PG8_SB(1, 0), cB + kstep, voffB); PG8_STAGE(PG8_SA(1, 0), cA + kstep, voffA); PG8_STAGE(PG8_SB(1, 1), cB + hstep + kstep, voffB);
        PG8_WAIT_V(6); PG8_BAR;
    }
    for (;;) {
        const bool has_next = S.next(ui + 1, nxt);
        const char* nA = has_next ? (const char*)g.A + (size_t)nxt.pm * tstep : cA; const char* nB = has_next ? (const char*)g.Bt + (size_t)nxt.pn * tstep + (HN ? (size_t)nxt.hn * hstep : (size_t)0) : cB;
        for (int t = 0; t < nt; t += 2) {
            const bool last = (t == nt - 2);
            const char* a1 = cA + (size_t)(t + 1) * kstep;
            const char* a2 = last ? nA : cA + (size_t)(t + 2) * kstep; const char* b2 = last ? nB : cB + (size_t)(t + 2) * kstep;
            const char* a3 = a2 + kstep; const char* b3 = b2 + kstep;
            if (last && has_next) S.a_ready(nxt);
            const int fae = __builtin_amdgcn_readfirstlane((Epi::MIN_STORES >= 8 && t == 0 && ui > 0) ? 1 : 0);
            if constexpr (HN) {
            PG8_LDB(B0, 0, 0); PG8_SCHED; PG8_LDA(At, 0, 0); PG8_STAGE(PG8_SA(1, 1), a1 + hstep, voffA);
            PG8_WAIT_V(6); PG8_WAIT_L(0); PG8_BAR; PG8_MMA(0, 0, At, B0); PG8_BAR; PG8_SCHED;
            PG8_LDA(At, 0, 1); PG8_STAGE(PG8_SB(0, 0), b2, voffB); PG8_STAGE(PG8_SA(0, 0), a2, voffA);
            PG8_WAIT_V(6); PG8_WAIT_L(0); PG8_BAR; PG8_MMA(1, 0, At, B0); PG8_BAR; PG8_SCHED;
            PG8_LDB(B0, 1, 0); PG8_SCHED; PG8_LDA(At, 1, 0); PG8_STAGE(PG8_SA(0, 1), a2 + hstep, voffA);
            PG8_WAIT_V(6); PG8_WAIT_L(0); PG8_BAR; PG8_MMA(0, 0, At, B0); PG8_BAR; PG8_SCHED;
            PG8_LDA(At, 1, 1); PG8_STAGE(PG8_SB(1, 0), b3, voffB); PG8_STAGE(PG8_SA(1, 0), a3, voffA);
            PG8_WAIT_V(6); PG8_WAIT_L(0); PG8_BAR; PG8_MMA(1, 0, At, B0); PG8_BAR; PG8_SCHED;
            } else if constexpr (SP2) {
            PG8_LDB(B0, 0, 0); PG8_LDB(B1, 0, 1); PG8_SCHED; PG8_LDA(At, 0, 0); PG8_STAGE(PG8_SA(1, 1), a1 + hstep, voffA);
            PG8_WAIT_V8_RELAX(fae); PG8_WAIT_L(0); PG8_BAR; PG8_MMA(0, 0, At, B0); PG8_MMA(0, 1, At, B1); PG8_BAR; PG8_SCHED;
            PG8_LDA(At, 0, 1); PG8_STAGE(PG8_SB(0, 0), b2, voffB); PG8_STAGE(PG8_SB(0, 1), b2 + hstep, voffB); PG8_STAGE(PG8_SA(0, 0), a2, voffA);
            PG8_WAIT_V8_RELAX(fae); PG8_WAIT_L(0); PG8_BAR; PG8_MMA(1, 0, At, B0); PG8_MMA(1, 1, At, B1); PG8_BAR; PG8_SCHED;
            PG8_LDB(B0, 1, 0); PG8_LDB(B1, 1, 1); PG8_SCHED; PG8_LDA(At, 1, 0); PG8_STAGE(PG8_SA(0, 1), a2 + hstep, voffA);
            PG8_WAIT_V(8); PG8_WAIT_L(0); PG8_BAR; PG8_MMA(0, 0, At, B0); PG8_MMA(0, 1, At, B1); PG8_BAR; PG8_SCHED;
            PG8_LDA(At, 1, 1); PG8_STAGE(PG8_SB(1, 0), b3, voffB); PG8_STAGE(PG8_SB(1, 1), b3 + hstep, voffB); PG8_STAGE(PG8_SA(1, 0), a3, voffA);
            PG8_WAIT_V(8); PG8_WAIT_L(0); PG8_BAR; PG8_MMA(1, 0, At, B0); PG8_MMA(1, 1, At, B1); PG8_BAR; PG8_SCHED;
            } else {
            PG8_LDB(B0, 0, 0); PG8_SCHED; PG8_LDA(At, 0, 0); PG8_STAGE(PG8_SA(1, 1), a1 + hstep, voffA);
            PG8_WAIT_L(8); PG8_BAR; PG8_WAIT_L(0); PG8_MMA(0, 0, At, B0); PG8_BAR; PG8_SCHED;
            PG8_LDB(B1, 0, 1); PG8_STAGE(PG8_SB(0, 0), b2, voffB);
            PG8_BAR; PG8_WAIT_L(0); PG8_MMA(0, 1, At, B1); PG8_BAR;
            PG8_LDA(At, 0, 1); PG8_STAGE(PG8_SA(0, 0), a2, voffA);
            PG8_BAR; PG8_WAIT_L(0); PG8_MMA(1, 0, At, B0); PG8_BAR; PG8_SCHED;
            PG8_STAGE(PG8_SB(0, 1), b2 + hstep, voffB);
            PG8_WAIT_V(6); PG8_BAR; PG8_MMA(1, 1, At, B1); PG8_BAR;
            PG8_LDB(B0, 1, 0); PG8_SCHED; PG8_LDA(At, 1, 0); PG8_STAGE(PG8_SA(0, 1), a2 + hstep, voffA);
            PG8_WAIT_L(8); PG8_BAR; PG8_WAIT_L(0); PG8_MMA(0, 0, At, B0); PG8_BAR; PG8_SCHED;
            PG8_LDB(B1, 1, 1); PG8_STAGE(PG8_SB(1, 0), b3, voffB);
            PG8_BAR; PG8_WAIT_L(0); PG8_MMA(0, 1, At, B1); PG8_BAR;
            PG8_LDA(At, 1, 1); PG8_STAGE(PG8_SA(1, 0), a3, voffA);
            PG8_BAR; PG8_WAIT_L(0); PG8_MMA(1, 0, At, B0); PG8_BAR; PG8_SCHED;
            PG8_STAGE(PG8_SB(1, 1), b3 + hstep, voffB);
            PG8_WAIT_V(6); PG8_BAR; PG8_MMA(1, 1, At, B1); PG8_BAR;
            }
        }
        if constexpr (ALIGN_EPI) { if (wr == 0) PG8_BAR; }
        if constexpr (!Epi::AFTER_DRAIN) { E(acc, cur, wr, wc, fr, fq); S.done(cur); }
        if (!has_next) break;
#pragma unroll
        for (int a = 0; a < 2; ++a)
#pragma unroll
            for (int b = 0; b < 2; ++b)
#pragma unroll
                for (int m = 0; m < 4; ++m)
#pragma unroll
                    for (int n = 0; n < 2; ++n) acc[a][b][m][n] = (f32x4){0.f, 0.f, 0.f, 0.f};
        cur = nxt; cA = nA; cB = nB; ++ui;
        if constexpr (ALIGN_EPI) { if (wr == 1) PG8_BAR; }
    }
    PG8_WAIT_V(0);
    if constexpr (!ALIGN_EPI) { if (wr == 0) PG8_BAR; }
    PG8_BAR;
    if constexpr (Epi::AFTER_DRAIN) { E.fused(acc, cur, wr, wc, fr, fq, lds, wid, lane); S.done(cur); }
#undef PG8_SA
#undef PG8_SB
#undef PG8_STAGE
#undef PG8_LDA
#undef PG8_LDB
#undef PG8_MMA
#undef PG8_WAIT_V
#undef PG8_WAIT_V8_RELAX
#undef PG8_WAIT_L
#undef PG8_BAR
#undef PG8_SCHED
}
}
#define GAS __attribute__((address_space(1)))
#define LAS __attribute__((address_space(3)))
typedef unsigned short bf16;
typedef unsigned v4u __attribute__((ext_vector_type(4)));
typedef float f32x4 __attribute__((ext_vector_type(4)));
typedef short bf16x8 __attribute__((ext_vector_type(8)));
typedef GAS unsigned gu32;
typedef GAS unsigned long long gu64;
#define RLX_AGENT __ATOMIC_RELAXED, __HIP_MEMORY_SCOPE_AGENT
#define LDS_WAIT() asm volatile("s_waitcnt lgkmcnt(0)" ::: "memory")
#define VM_WAIT() asm volatile("s_waitcnt vmcnt(0)" ::: "memory")
__device__ __forceinline__ unsigned long long rt() { return __builtin_amdgcn_s_memrealtime(); }
__device__ __forceinline__ unsigned f2bf(float f) { unsigned u = __builtin_bit_cast(unsigned, f); return (u + 0x7fffu + ((u >> 16) & 1u)) >> 16; }
typedef float pk_f32x2_t __attribute__((ext_vector_type(2))); typedef __bf16 pk_bf16x2_t __attribute__((ext_vector_type(2)));
__device__ __forceinline__ unsigned pk2(float lo, float hi) { pk_f32x2_t v = {lo, hi}; pk_bf16x2_t b = __builtin_convertvector(v, pk_bf16x2_t); return __builtin_bit_cast(unsigned, b); }

#define XB_TMO      128
#define XB_XCNT(j)  (256  + 64 * (j))
#define XB_XSUB(j)  (1280 + 64 * (j))
#define XB_XGEN(j)  (2304 + 64 * (j))
#define XB_TOP      3328
#define XB_TOPGEN   3392
#define XCD_BAR_WORDS 3456
#define XB_SPIN_CAP (1u << 18)

__device__ __forceinline__ unsigned xb_ld(unsigned* p)              { return __hip_atomic_load(p, __ATOMIC_RELAXED, __HIP_MEMORY_SCOPE_AGENT); }
__device__ __forceinline__ unsigned xb_add(unsigned* p, unsigned v) { return __hip_atomic_fetch_add(p, v, __ATOMIC_RELAXED, __HIP_MEMORY_SCOPE_AGENT); }
__device__ __forceinline__ unsigned xb_xcc_id() { return (unsigned)__builtin_amdgcn_s_getreg((3 << 11) | 20) & 0xFu; }
#define XB_SPIN(cond, bar) do { unsigned _sp = 0; while (cond) { __builtin_amdgcn_s_sleep(1); \
    if ((++_sp & 255u) == 0u) { if (xb_ld(&(bar)[XB_TMO])) break; if (_sp > XB_SPIN_CAP) { atomicAdd(&(bar)[XB_TMO], 1u); break; } } } } while (0)

struct XcdBarrier {
    unsigned* bar; unsigned x; int wave;
    volatile LAS unsigned* st;
};

__device__ __forceinline__ XcdBarrier xcd_barrier_post(unsigned* bar, volatile LAS unsigned* st) {
    XcdBarrier b; b.bar = bar; b.x = xb_xcc_id(); b.st = st;
    if (threadIdx.x == 0) (void)xb_add(&bar[XB_XCNT(b.x)], 1u);
    return b;
}
__device__ __forceinline__ void xcd_barrier_complete(unsigned* bar, unsigned x, unsigned& nloc, unsigned& nx) {
    const unsigned G = gridDim.x * gridDim.y * gridDim.z;
    unsigned sum, cnt, mine, sp = 0u;
    for (;;) {
        sum = 0u; cnt = 0u; mine = 0u;
#pragma unroll
        for (unsigned j = 0; j < 16; ++j) { const unsigned c = xb_ld(&bar[XB_XCNT(j)]); sum += c; cnt += (c > 0u) ? 1u : 0u; mine = (j == x) ? c : mine; }
        if (sum == G) break;
        __builtin_amdgcn_s_sleep(1);
        if ((++sp & 255u) == 0u) { if (xb_ld(&bar[XB_TMO])) break; if (sp > XB_SPIN_CAP) { atomicAdd(&bar[XB_TMO], 1u); break; } }
    }
    nloc = mine > 0u ? mine : 1u; nx = cnt > 0u ? cnt : 1u;
}

__device__ __forceinline__ void xcd_barrier(const XcdBarrier& b) {
    asm volatile("s_waitcnt vmcnt(0)" ::: "memory");
    __syncthreads();
    if (b.wave == 0 && mk_lane() == 0) {
        unsigned* bar = b.bar;
        __builtin_amdgcn_s_waitcnt(0);
        unsigned nloc = b.st[0], nx = b.st[1];
        if (nloc == 0u) { xcd_barrier_complete(bar, b.x, nloc, nx); b.st[0] = nloc; b.st[1] = nx; }
        const unsigned old = xb_add(&bar[XB_XSUB(b.x)], 1u);
        const unsigned gen = old / nloc;
        if (old + 1u == (gen + 1u) * nloc) {
            __builtin_amdgcn_fence(__ATOMIC_RELEASE, "agent");
            asm volatile("s_waitcnt vmcnt(0)" ::: "memory");
            const unsigned og = xb_add(&bar[XB_TOP], 1u);
            const unsigned tg = og / nx;
            if (og + 1u == (tg + 1u) * nx) xb_add(&bar[XB_TOPGEN], 1u);
            else XB_SPIN(xb_ld(&bar[XB_TOPGEN]) == tg, bar);
            __builtin_amdgcn_fence(__ATOMIC_ACQUIRE, "agent");
            xb_add(&bar[XB_XGEN(b.x)], 1u);
            asm volatile("s_waitcnt vmcnt(0)" ::: "memory");
        } else {
            XB_SPIN(xb_ld(&bar[XB_XGEN(b.x)]) == gen, bar);
            __builtin_amdgcn_fence(__ATOMIC_ACQUIRE, "agent");
            asm volatile("s_waitcnt vmcnt(0)" ::: "memory");
        }
    }
    __syncthreads();
}

struct Args { const float* in[N_IN]; float* out; unsigned char* ws; int ph_lo, ph_hi, att_reps, conv_reps; };
static_assert(sizeof(Args) == N_IN * 8 + 8 + 8 + 16, "Args has no padding");
#define GB_CEN(g, x) (1024 + 16 * (g) + (x))
#define GB_SUB(g)    (2048 + 64 * (g))
#define GB_GEN(g)    (3072 + 64 * (g))
#define P0_ROWQ(g)   (3584 + 64 * (g))
__device__ __forceinline__ void group_barrier(unsigned* ctl, unsigned* bar, volatile LAS unsigned* st, int wave) {
    asm volatile("s_waitcnt vmcnt(0)" ::: "memory");
    __syncthreads();
    if (wave == 0 && mk_lane() == 0) {
        __builtin_amdgcn_s_waitcnt(0);
        const unsigned g = blockIdx.x & 7u, NG = GRID_WG / 8;
        unsigned mode = st[0];
        if (mode == 0u) {
            unsigned sp = 0u;
            for (;;) { unsigned sum = 0u, nz = 0u;
#pragma unroll
                for (unsigned j = 0; j < 16; ++j) { const unsigned c = xb_ld(&ctl[GB_CEN(g, j)]); sum += c; nz += (c > 0u) ? 1u : 0u; }
                if (sum == NG) { mode = nz == 1u ? 1u : 2u; break; }
                __builtin_amdgcn_s_sleep(1);
                if ((++sp & 255u) == 0u && (xb_ld(&bar[XB_TMO]) || sp > XB_SPIN_CAP)) { mode = 2u; break; } }
            st[0] = mode;
        }
        if (mode != 1u) { __builtin_amdgcn_fence(__ATOMIC_RELEASE, "agent"); asm volatile("s_waitcnt vmcnt(0)" ::: "memory"); }
        const unsigned old = xb_add(&ctl[GB_SUB(g)], 1u), gen = old / NG;
        if (old + 1u == (gen + 1u) * NG) xb_add(&ctl[GB_GEN(g)], 1u);
        else XB_SPIN(xb_ld(&ctl[GB_GEN(g)]) == gen, bar);
        __builtin_amdgcn_fence(__ATOMIC_ACQUIRE, "agent");
        asm volatile("s_waitcnt vmcnt(0)" ::: "memory");
    }
    __syncthreads();
}

struct Frame {
    LAS unsigned char* lds;
    volatile LAS unsigned* MISC;
    gu32* ctl;
    int tid, lane, wave;
    int vcu, G;
    unsigned char* ws;
};
__device__ __forceinline__ bf16* w_ptr(const Frame& F, int l, size_t off) { return (bf16*)(F.ws + WS_W + (size_t)l * W_LAYER + off); }
__device__ __forceinline__ float bf2f(bf16 v) { return __uint_as_float((unsigned)v << 16); }
__device__ __forceinline__ float wave_sum(float v) {
    v = wave_sum_fast(v);
    return v;
}
__device__ __forceinline__ float wave_max(float v) {
#pragma unroll
    for (int o = 1; o < 64; o <<= 1) v = fmaxf(v, __shfl_xor(v, o));
    return v;
}
__device__ const unsigned char REL_BUCKET_TAB[128] = {
    0, 1, 2, 3, 4, 5, 6, 7, 8, 9, 10, 11, 12, 13, 14, 15, 16, 16, 16, 17, 17, 18, 18, 18, 19, 19, 19, 20, 20, 20, 20, 21, 21, 21, 21, 22, 22, 22, 22, 22, 23, 23, 23, 23, 23, 23, 24, 24, 24, 24, 24, 24,
    25, 25, 25, 25, 25, 25, 25, 26, 26, 26, 26, 26, 26, 26, 26, 27, 27, 27, 27, 27, 27, 27, 27, 27, 27, 28, 28, 28, 28, 28, 28, 28, 28, 28, 28, 29, 29, 29, 29, 29, 29, 29, 29, 29, 29, 29, 29,
    30, 30, 30, 30, 30, 30, 30, 30, 30, 30, 30, 30, 30, 30, 31, 31, 31, 31, 31, 31, 31, 31, 31, 31, 31, 31, 31, 31, 31};

__device__ __forceinline__ void st16_wt(void* p, v4u v) { asm volatile("global_store_dwordx4 %0, %1, off sc0 sc1\n\ts_nop 1" :: "v"(p), "v"(v) : "memory"); }
struct TItem { const float* W; const float* gain; bf16* WT; int K, N, dst, k0, n0; };
__device__ __forceinline__ void titem_load(const TItem& t, float (&v)[32], int lane) {
    const unsigned loff = (unsigned)((lane >> 5) * t.N + (lane & 31));
#pragma unroll
    for (int i = 0; i < 32; ++i) { const float* rp = t.W + (size_t)(t.k0 + 2 * i) * t.N + t.n0; v[i] = __builtin_nontemporal_load(rp + loff); }
}
__device__ __forceinline__ void titem_finish(const TItem& t, const float (&v)[32], LAS float* scr, int lane) {
#pragma unroll
    for (int i = 0; i < 32; ++i) { const int kk = 2 * i + (lane >> 5); float x = v[i]; if (t.gain) x *= t.gain[t.k0 + kk]; scr[kk * 33 + (lane & 31)] = x; }
    LDS_WAIT(); asm volatile("" ::: "memory");
    const int c = lane & 7;
#pragma unroll
    for (int j = 0; j < 4; ++j) { const int n = (lane >> 3) + 8 * j; const LAS float* s = scr + (8 * c) * 33 + n;
        v4u o; o.x = pk2(s[0 * 33], s[1 * 33]); o.y = pk2(s[2 * 33], s[3 * 33]); o.z = pk2(s[4 * 33], s[5 * 33]); o.w = pk2(s[6 * 33], s[7 * 33]);
        st16_wt((void*)(t.WT + (size_t)(t.dst + n) * t.K + t.k0 + 8 * c), o); }
    LDS_WAIT(); asm volatile("" ::: "memory");
}
__device__ __forceinline__ void p0_poolfold_item(const float* Wout, const float* pw, const float* ps, bf16* WT, int g, int n0, LAS float* scr, int lane_) {
    int lane = lane_; asm volatile("" : "+v"(lane));
    { const float* wr = Wout + (size_t)(g * 64 + lane) * D + n0; const float sc = ps[g * 64 + lane];
      *(LAS f32x4*)(scr + lane * 8) = *(const f32x4*)wr * sc; *(LAS f32x4*)(scr + lane * 8 + 4) = *(const f32x4*)(wr + 4) * sc; }
    LDS_WAIT(); asm volatile("" ::: "memory");
    f32x4 a0 = {0.f, 0.f, 0.f, 0.f}, a1 = {0.f, 0.f, 0.f, 0.f};
#pragma unroll 1
    for (int q = 0; q < 4; ++q) {
        f32x4 pr[4];
#pragma unroll
        for (int j = 0; j < 4; ++j) pr[j] = *(const f32x4*)(pw + (size_t)(g * 64 + lane) * 64 + 16 * q + 4 * j);
#pragma unroll
        for (int dd = 0; dd < 16; ++dd) { const float p = pr[dd >> 2][dd & 3]; const LAS float* sp = scr + (16 * q + dd) * 8; a0 += *(const LAS f32x4*)sp * p; a1 += *(const LAS f32x4*)(sp + 4) * p; }
    }
    bf16* o = WT + (size_t)n0 * D + g * 64 + lane;
#pragma unroll
    for (int e = 0; e < 4; ++e) { o[(size_t)e * D] = (bf16)f2bf(a0[e]); o[(size_t)(4 + e) * D] = (bf16)f2bf(a1[e]); }
    LDS_WAIT(); asm volatile("" ::: "memory");
}
constexpr int I_IN = (D / 64) * (DIN / 32), I_OUTT = (D / 64 - 4) * (D / 32), I_G = (D / 64) * (DFF / 32), I_DN = (DFF / 64) * (D / 32), PER_L = I_IN + I_OUTT + 2 * I_G + I_DN, I_FOLD = 4 * (D / 8);
__device__ __forceinline__ TItem titem_decode(Frame& F, const Args& A, int it) {
    const int l = it / PER_L; int r = it % PER_L; TItem t;
    if (r < I_IN) { const int nb = DIN / 32, kb = r / nb, n0 = 32 * (r % nb);
        int dst = n0;
        if (n0 >= 512 && n0 < 1536) { const int q4 = (n0 - 512) >> 8, j = (n0 - 512) & 255; dst = 512 + 512 * (q4 >> 1) + 256 * (j >> 7) + 128 * (q4 & 1) + (j & 127); }
        t = TItem{A.in[I_WIN] + (size_t)l * D * DIN, A.in[I_N1G] + l * D, w_ptr(F, l, WOFF_IN), D, DIN, dst, 64 * kb, n0}; return t; } r -= I_IN;
    if (r < I_OUTT) { const int nb = D / 32, kb = 4 + r / nb, n0 = 32 * (r % nb);
        t = TItem{A.in[I_WOUT] + (size_t)l * D * D, nullptr, w_ptr(F, l, WOFF_OUT), D, D, n0, 64 * kb, n0}; return t; } r -= I_OUTT;
    if (r < 2 * I_G) { const int up = r >= I_G; if (up) r -= I_G; const int nb = DFF / 32, kb = r / nb, n0 = 32 * (r % nb);
        const int dst = 256 * (n0 / 128) + 128 * up + (n0 % 128);
        t = TItem{A.in[up ? I_WUP : I_WGATE] + (size_t)l * D * DFF, A.in[I_N2G] + l * D, w_ptr(F, l, WOFF_GU), D, DFF, dst, 64 * kb, n0}; return t; } r -= 2 * I_G;
    { const int nb = D / 32, kb = r / nb, n0 = 32 * (r % nb);
        t = TItem{A.in[I_WDOWN] + (size_t)l * DFF * D, nullptr, w_ptr(F, l, WOFF_DN), DFF, D, n0, 64 * kb, n0}; return t; }
}
__device__ __forceinline__ void p0_weight_items(Frame& F, const Args& A, int gw, int NGW, int wave, int lane) {
    LAS float* scr = (LAS float*)(F.lds + RING_OFF + wave * 16384);
    for (int k = gw; k < DEPTH * I_FOLD; k += NGW) { const int l = k / I_FOLD, r = k % I_FOLD;
        p0_poolfold_item(A.in[I_WOUT] + (size_t)l * D * D, A.in[I_POOLW] + (size_t)l * 4 * 64 * 64, A.in[I_POOLS] + l * 256, w_ptr(F, l, WOFF_OUT), r / (D / 8), 8 * (r % (D / 8)), scr, lane); }
    for (int k = gw; k < DEPTH * PER_L; k += 2 * NGW) {
        const TItem t0 = titem_decode(F, A, k); float v0[32], v1[32]; titem_load(t0, v0, lane);
        const bool two = k + NGW < DEPTH * PER_L; const TItem t1 = titem_decode(F, A, two ? k + NGW : k);
        if (two) titem_load(t1, v1, lane);
        titem_finish(t0, v0, scr, lane);
        if (two) titem_finish(t1, v1, scr, lane);
    }
}
__device__ __forceinline__ void p0_prologue(Frame& F, const Args& A) {
    int tid_ = mk_tid(F.wave); asm volatile("" : "+v"(tid_));
    const int lane = tid_ & 63, wave = __builtin_amdgcn_readfirstlane(tid_ >> 6);
    const int gw = F.vcu * NWAVES + wave, NGW = F.G * NWAVES;
    p0_weight_items(F, A, (int)(blockIdx.x & (GRID_WG - 1)) * NWAVES + wave, NGW, wave, lane);
    const float* x = A.in[I_X];
    unsigned* const rq = (unsigned*)F.ctl + P0_ROWQ(blockIdx.x & 7u);
    const int rbase = (int)(blockIdx.x & 7u) * (M / 8);
#define P0_FETCH(raw) do { raw = 0u; if (lane == 0) raw = __hip_atomic_fetch_add(rq, 1u, __ATOMIC_RELAXED, __HIP_MEMORY_SCOPE_AGENT); } while (0)
    int c = (int)((blockIdx.x & (GRID_WG - 1)) >> 3) * NWAVES + wave;
    while (c < M / 8 / 4) {
        unsigned fn; P0_FETCH(fn); fn += 256u;
        const int m0 = rbase + 4 * c;
        f32x4 v[4][4];
#pragma unroll
        for (int q = 0; q < 4; ++q) { const int m = m0 + q; const GAS f32x4* xr = (const GAS f32x4*)(x + (size_t)m * D) + 2 * lane;
#pragma unroll
            for (int h = 0; h < 2; ++h) { v[q][2 * h] = __builtin_nontemporal_load(xr + 128 * h); v[q][2 * h + 1] = __builtin_nontemporal_load(xr + 128 * h + 1); } }
#pragma unroll
        for (int q = 0; q < 4; ++q) { const int m = m0 + q; float s = 0.f;
#pragma unroll
            for (int j = 0; j < 4; ++j) s += (v[q][j].x * v[q][j].x + v[q][j].y * v[q][j].y) + (v[q][j].z * v[q][j].z + v[q][j].w * v[q][j].w);
            s = wave_sum(s);
            bf16* xbr = ((bf16*)(F.ws + WS_XB)) + (size_t)m * D;
#pragma unroll
            for (int h = 0; h < 2; ++h) { v4u o; o.x = pk2(v[q][2 * h].x, v[q][2 * h].y); o.y = pk2(v[q][2 * h].z, v[q][2 * h].w); o.z = pk2(v[q][2 * h + 1].x, v[q][2 * h + 1].y); o.w = pk2(v[q][2 * h + 1].z, v[q][2 * h + 1].w);
                st16_wt((void*)(xbr + 512 * h + 8 * lane), o); }
            if (lane < 16) ((float*)(F.ws + WS_PART))[(size_t)m * 16 + lane] = (lane == 0) ? s : 0.f; }
        c = __builtin_amdgcn_readfirstlane((int)fn);
    }
#undef P0_FETCH
}

namespace att {
typedef short bf16x8 __attribute__((ext_vector_type(8)));
typedef float f32x16 __attribute__((ext_vector_type(16)));
typedef short v4s __attribute__((ext_vector_type(4)));
constexpr int SLOTB = 16384, NSLOT = 3, TAB_OFF = NSLOT * SLOTB;
constexpr float LOG2E = 1.4426950408889634f;
__device__ __forceinline__ void glds16(const void* gsrc, unsigned lds_dst) { unsigned keep;
    asm volatile("s_mov_b32 %0, m0\n\ts_mov_b32 m0, %2\n\ts_nop 0\n\tglobal_load_lds_dwordx4 %1, off\n\ts_mov_b32 m0, %0" : "=&s"(keep) : "v"(gsrc), "s"(lds_dst) : "memory"); }
typedef float f32x2_t __attribute__((ext_vector_type(2))); typedef __bf16 bf16x2_t __attribute__((ext_vector_type(2)));
__device__ __forceinline__ unsigned cvtpk(float lo, float hi) { f32x2_t v = {lo, hi}; bf16x2_t b = __builtin_convertvector(v, bf16x2_t); return __builtin_bit_cast(unsigned, b); }
template <int ABL> __device__ __forceinline__ void attn_unit(LAS unsigned char* lds, const bf16* Qn, const unsigned char* Kimg, const unsigned char* Vimg, bf16* MIX, const float* relb, const float* subg,
                                          int b, int h, int qb, float negB, float lam, float oml, int tid, int lane, int wid) {
    (void)relb; (void)subg;
    const int ql = lane & 31, hh = lane >> 5;
    const int qw = qb * 256 + 32 * wid;
    const int NT = 4 * qb + 4, jl = 4 * qb + (wid >> 1);
    const LAS unsigned char* rtab = lds + TAB_OFF + 256 + h * 1280;
    const LAS float* sgl = (const LAS float*)(lds + TAB_OFF);
    const size_t rowq = (size_t)b * SEQ + qw + ql;
    const unsigned char* ksrc = Kimg + ((size_t)((b * 4 + h) * 32) << 13) + wid * 1024 + lane * 16;
    const unsigned char* vsrc = Vimg + ((size_t)((b * 4 + h) * 32) << 13) + wid * 1024 + lane * 16;
    const unsigned ldsb = (unsigned)(uintptr_t)lds;
#define ATT_DMA(t, slot) do { \
        glds16(ksrc + ((size_t)(t) << 13), (unsigned)__builtin_amdgcn_readfirstlane(ldsb + (slot) * SLOTB + wid * 1024)); \
        glds16(vsrc + ((size_t)(t) << 13), (unsigned)__builtin_amdgcn_readfirstlane(ldsb + (slot) * SLOTB + 8192 + wid * 1024)); } while (0)
    f32x16 O[2][2];
#pragma unroll
    for (int m = 0; m < 2; ++m)
#pragma unroll
        for (int d = 0; d < 2; ++d)
#pragma unroll
            for (int r = 0; r < 16; ++r) O[m][d][r] = 0.f;
    float l0 = 0.f, l1 = 0.f;
    (void)negB;
    ATT_DMA(0, 0); ATT_DMA(1, 1);
    bf16x8 qf[2][2];
#pragma unroll
    for (int m = 0; m < 2; ++m)
#pragma unroll
        for (int s = 0; s < 2; ++s) qf[m][s] = *(const bf16x8*)(Qn + rowq * 256 + (2 * h + m) * 32 + 16 * s + 8 * hh);
    __builtin_amdgcn_s_waitcnt(0x0F70);
    int slot = 0, slot2 = 2;
    for (int t = 0; t < NT; ++t) {
        if (t + 1 < NT) asm volatile("s_waitcnt vmcnt(2) lgkmcnt(0)" ::: "memory"); else asm volatile("s_waitcnt vmcnt(0) lgkmcnt(0)" ::: "memory");
        __builtin_amdgcn_s_barrier(); asm volatile("" ::: "memory");
        if (t + 2 < NT) ATT_DMA(t + 2, slot2);
        if (t <= jl) {
            const LAS unsigned char* kS = lds + slot * SLOTB; const LAS unsigned char* vS = kS + 8192;
            const int vlane = 64 * (4 * hh + ((lane & 15) >> 2)) + 32 * ((lane >> 4) & 1) + 8 * (lane & 3);
            const bool near = qw - (64 * t + 63) < 113;
            const LAS float* rp = (const LAS float*)(rtab + 4 * (224 - ((qw + ql) - 64 * t - 4 * hh)));
            bf16x8 kf[2][2][2];
#pragma unroll
            for (int m = 0; m < 2; ++m)
#pragma unroll
                for (int blk = 0; blk < 2; ++blk)
#pragma unroll
                    for (int s = 0; s < 2; ++s) { const int kv = 32 * blk + ql; kf[m][blk][s] = *(const LAS bf16x8*)(kS + kv * 128 + (((m * 4 + 2 * s + hh) ^ ((kv >> 1) & 7)) << 4)); }
            __builtin_amdgcn_sched_barrier(0);
            f32x16 S[2][2]; bf16x8 pk[2][2][2];
#define ATT_SMAP(m) do { f32x16 z0, z1; _Pragma("unroll") for (int r = 0; r < 16; ++r) { z0[r] = 0.f; z1[r] = 0.f; } \
                z0 = __builtin_amdgcn_mfma_f32_32x32x16_bf16(kf[m][0][0], qf[m][0], z0, 0, 0, 0); z1 = __builtin_amdgcn_mfma_f32_32x32x16_bf16(kf[m][1][0], qf[m][0], z1, 0, 0, 0); \
                S[m][0] = __builtin_amdgcn_mfma_f32_32x32x16_bf16(kf[m][0][1], qf[m][1], z0, 0, 0, 0); S[m][1] = __builtin_amdgcn_mfma_f32_32x32x16_bf16(kf[m][1][1], qf[m][1], z1, 0, 0, 0); } while (0)
#define ATT_BIAS(m) do { if (near) { _Pragma("unroll") for (int blk = 0; blk < 2; ++blk) { float bv[16]; \
                _Pragma("unroll") for (int r = 0; r < 16; ++r) bv[r] = rp[32 * blk + (r & 3) + 8 * (r >> 2)]; \
                _Pragma("unroll") for (int r = 0; r < 16; ++r) S[m][blk][r] += bv[r]; } } } while (0)
#define ATT_EXPMAP(m, lacc) do { _Pragma("unroll") for (int blk = 0; blk < 2; ++blk) { float ls[4] = {0.f, 0.f, 0.f, 0.f};     \
                _Pragma("unroll") for (int r = 0; r < 16; ++r) { const float p = __builtin_amdgcn_exp2f(S[m][blk][r]); S[m][blk][r] = p; ls[r & 3] += p; } \
                lacc += (ls[0] + ls[1]) + (ls[2] + ls[3]); \
                _Pragma("unroll") for (int s = 0; s < 2; ++s) { v4u w; \
                    w.x = cvtpk(S[m][blk][8 * s + 0], S[m][blk][8 * s + 1]); w.y = cvtpk(S[m][blk][8 * s + 2], S[m][blk][8 * s + 3]); \
                    w.z = cvtpk(S[m][blk][8 * s + 4], S[m][blk][8 * s + 5]); w.w = cvtpk(S[m][blk][8 * s + 6], S[m][blk][8 * s + 7]); \
                    pk[m][blk][s] = __builtin_bit_cast(bf16x8, w); } } } while (0)
            ATT_SMAP(0);
            __builtin_amdgcn_sched_barrier(0);
            ATT_BIAS(0);
            __builtin_amdgcn_sched_barrier(0);
            ATT_SMAP(1);
            ATT_EXPMAP(0, l0);

            __builtin_amdgcn_sched_barrier(0);
            ATT_BIAS(1);
            v4s vlo[2][2][2], vhi[2][2][2];
#pragma unroll
            for (int db = 0; db < 2; ++db)
#pragma unroll
                for (int blk = 0; blk < 2; ++blk)
#pragma unroll
                    for (int s = 0; s < 2; ++s) { const LAS unsigned char* vp = vS + vlane + 1024 * (4 * blk + 2 * s) + 512 * db;
                        vlo[db][blk][s] = __builtin_bit_cast(v4s, __builtin_amdgcn_ds_read_tr16_b64_v4i16((LAS v4s*)vp)); vhi[db][blk][s] = __builtin_bit_cast(v4s, __builtin_amdgcn_ds_read_tr16_b64_v4i16((LAS v4s*)(vp + 1024))); }
            __builtin_amdgcn_sched_barrier(0);
#pragma unroll
            for (int db = 0; db < 2; ++db)
#pragma unroll
                for (int blk = 0; blk < 2; ++blk)
#pragma unroll
                    for (int s = 0; s < 2; ++s) { const v4s lo = vlo[db][blk][s], hi = vhi[db][blk][s];
                        const bf16x8 vf = (bf16x8){lo[0], lo[1], lo[2], lo[3], hi[0], hi[1], hi[2], hi[3]};
                        O[0][db] = __builtin_amdgcn_mfma_f32_32x32x16_bf16(vf, pk[0][blk][s], O[0][db], 0, 0, 0); }
            ATT_EXPMAP(1, l1);

            __builtin_amdgcn_sched_barrier(0);
#pragma unroll
            for (int db = 0; db < 2; ++db)
#pragma unroll
                for (int blk = 0; blk < 2; ++blk)
#pragma unroll
                    for (int s = 0; s < 2; ++s) { const v4s lo = vlo[db][blk][s], hi = vhi[db][blk][s];
                        const bf16x8 vf = (bf16x8){lo[0], lo[1], lo[2], lo[3], hi[0], hi[1], hi[2], hi[3]};
                        O[1][db] = __builtin_amdgcn_mfma_f32_32x32x16_bf16(vf, pk[1][blk][s], O[1][db], 0, 0, 0); }
            __builtin_amdgcn_sched_barrier(0);
#undef ATT_SMAP
#undef ATT_BIAS
#undef ATT_EXPMAP
        }
        slot = slot == NSLOT - 1 ? 0 : slot + 1; slot2 = slot2 == NSLOT - 1 ? 0 : slot2 + 1;
    }
#undef ATT_DMA
    l0 += __shfl_xor(l0, 32); l1 += __shfl_xor(l1, 32);
    const float i0 = 1.0f / l0, i1 = lam / l1;
    float ss = 0.f;
#pragma unroll
    for (int db = 0; db < 2; ++db)
#pragma unroll
        for (int r = 0; r < 16; ++r) { const float v = O[0][db][r] * i0 - O[1][db][r] * i1; O[0][db][r] = v; ss += v * v; }
    ss += __shfl_xor(ss, 32);
    const float rn = rsqrtf(ss * (1.0f / 64.0f) + EPS) * oml;
    bf16* orow = MIX + rowq * D + 768 + h * 64;
#pragma unroll
    for (int db = 0; db < 2; ++db)
#pragma unroll
        for (int g4 = 0; g4 < 4; ++g4) { const int d0 = 32 * db + 8 * g4 + 4 * hh; const f32x4 gg = *(const LAS f32x4*)(sgl + d0);
            const unsigned lo = cvtpk(O[0][db][4 * g4 + 0] * rn * gg[0], O[0][db][4 * g4 + 1] * rn * gg[1]), hi = cvtpk(O[0][db][4 * g4 + 2] * rn * gg[2], O[0][db][4 * g4 + 3] * rn * gg[3]);
            *(unsigned long long*)(orow + d0) = (unsigned long long)lo | ((unsigned long long)hi << 32); }
    asm volatile("s_waitcnt lgkmcnt(0)" ::: "memory"); __builtin_amdgcn_s_barrier(); asm volatile("" ::: "memory");
}
}

constexpr int CONV_US = 0, CONV_CS = 49152, CONV_WS = 114688;
static_assert(CONV_WS + 31 * 256 * 4 <= PHASE_LDS, "conv LDS map");
__device__ __forceinline__ void conv_unit(LAS unsigned char* lds, const bf16* ZC, bf16* MIX, const float* sconv_w, const float* cdw_b, const float* cln_g, const float* cln_b,
                                          int b, int ch, int tid, int lane, int wid) {
    const int t0 = ch * 64; const size_t row0 = (size_t)b * SEQ + t0;
    LAS unsigned* Us = (LAS unsigned*)(lds + CONV_US);
    LAS float* Cs = (LAS float*)(lds + CONV_CS);
    const LAS float* Ws = (const LAS float*)(lds + CONV_WS);
    { v4u v[6];
#pragma unroll
      for (int k = 0; k < 6; ++k) { const int i = tid + k * NWAVES * 64, r = i >> 5, c16 = i & 31; v[k] = (v4u){0u, 0u, 0u, 0u};
          if (i < 94 * 32 && t0 - 30 + r >= 0) v[k] = *(const v4u*)(ZC + (row0 - 30 + r) * 1024 + 768 + c16 * 8); }
#pragma unroll
      for (int k = 0; k < 6; ++k) { const int i = tid + k * NWAVES * 64; if (i < 94 * 32) *(LAS v4u*)(lds + CONV_US + (i >> 5) * 512 + (i & 31) * 16) = v[k]; } }
    { const int g = wid & 3, win = 2 << g, cg = 8 * g + (lane & 7), tq = (lane >> 3) + 8 * (wid >> 2), pos = t0 + 4 * tq; const size_t row = row0 + 4 * tq;
      const bf16* zp = ZC + row * 1024 + 8 * cg;
      float s[8];
#pragma unroll
      for (int e = 0; e < 8; ++e) s[e] = 0.f;
      { v4u wv[15];
#pragma unroll
        for (int j = 1; j < 16; ++j) { wv[j - 1] = (v4u){0u, 0u, 0u, 0u}; if (j < win && pos - j >= 0) wv[j - 1] = *(const v4u*)(zp - (size_t)j * 1024); }
#pragma unroll
        for (int j = 0; j < 15; ++j)
#pragma unroll
          for (int e = 0; e < 4; ++e) { s[2 * e] += __uint_as_float(wv[j][e] << 16); s[2 * e + 1] += __uint_as_float(wv[j][e] & 0xffff0000u); } }
      v4u cur[4], old[4], pp[6], sb[4];
#pragma unroll
      for (int i = 0; i < 4; ++i) { cur[i] = *(const v4u*)(zp + (size_t)i * 1024); old[i] = (v4u){0u, 0u, 0u, 0u};
          if (pos + i + 1 >= win) old[i] = *(const v4u*)(zp + (size_t)i * 1024 - (size_t)(win - 1) * 1024);
          sb[i] = *(const v4u*)(zp + (size_t)i * 1024 + 256 + 0); }
#pragma unroll
      for (int i = 0; i < 6; ++i) { pp[i] = (v4u){0u, 0u, 0u, 0u}; if (pos - 2 + i >= 0) pp[i] = *(const v4u*)(ZC + (row - 2 + i) * 1024 + 512 + 8 * cg); }
      float w0[8], w1[8], w2[8];
#pragma unroll
      for (int e = 0; e < 8; e += 4) { const f32x4 a = *(const f32x4*)(sconv_w + 8 * cg + e), bq = *(const f32x4*)(sconv_w + 256 + 8 * cg + e), cq = *(const f32x4*)(sconv_w + 512 + 8 * cg + e);
#pragma unroll
          for (int k = 0; k < 4; ++k) { w0[e + k] = a[k]; w1[e + k] = bq[k]; w2[e + k] = cq[k]; } }
#pragma unroll
      for (int i = 0; i < 4; ++i) { const int t = pos + i; const float rc = 1.0f / (float)((t + 1) < win ? (t + 1) : win);
          float po[8], so[8];
#pragma unroll
          for (int e = 0; e < 8; ++e) { const unsigned cw = cur[i][e >> 1], ow = old[i][e >> 1], bw = sb[i][e >> 1], q0 = pp[i][e >> 1], q1 = pp[i + 1][e >> 1], q2 = pp[i + 2][e >> 1];
#define BFSEL(w) ((e & 1) ? __uint_as_float((w) & 0xffff0000u) : __uint_as_float((w) << 16))
              const float u = BFSEL(cw); s[e] += u; po[e] = s[e] * rc - u; s[e] -= BFSEL(ow);
              so[e] = BFSEL(bw) * (w0[e] * BFSEL(q0) + w1[e] * BFSEL(q1) + w2[e] * BFSEL(q2));
#undef BFSEL
          }
          v4u o1, o2; o1.x = pk2(po[0], po[1]); o1.y = pk2(po[2], po[3]); o1.z = pk2(po[4], po[5]); o1.w = pk2(po[6], po[7]);
          o2.x = pk2(so[0], so[1]); o2.y = pk2(so[2], so[3]); o2.z = pk2(so[4], so[5]); o2.w = pk2(so[6], so[7]);
          *(v4u*)(MIX + (row + i) * D + 8 * cg) = o1; *(v4u*)(MIX + (row + i) * D + 256 + 8 * cg) = o2; } }
    __syncthreads();
    { const int cp = tid & 127, tg = tid >> 7;
      float a0[16], a1[16]; const float b0 = cdw_b[2 * cp], b1 = cdw_b[2 * cp + 1];
#pragma unroll
      for (int i = 0; i < 16; ++i) { a0[i] = b0; a1[i] = b1; }
      float x0[46], x1[46];
#pragma unroll
      for (int r = 0; r < 46; ++r) { const unsigned u = Us[(16 * tg + r) * 128 + cp]; x0[r] = __uint_as_float(u << 16); x1[r] = __uint_as_float(u & 0xffff0000u); }
#pragma unroll
      for (int j = 0; j < 31; ++j) { typedef float f32x2v __attribute__((ext_vector_type(2))); const f32x2v w = *(const LAS f32x2v*)(Ws + j * 256 + 2 * cp);
#pragma unroll
          for (int i = 0; i < 16; ++i) { a0[i] += w.x * x0[i + j]; a1[i] += w.y * x1[i + j]; } }
#pragma unroll
      for (int i = 0; i < 16; ++i) { typedef float f32x2v __attribute__((ext_vector_type(2))); *(LAS f32x2v*)(Cs + (16 * tg + i) * 256 + 2 * cp) = (f32x2v){a0[i], a1[i]}; } }
    __syncthreads();
    { const f32x4 gg = *(const f32x4*)(cln_g + lane * 4), bb = *(const f32x4*)(cln_b + lane * 4);
#pragma unroll 1
      for (int k0 = 0; k0 < 8; k0 += 4) {
      f32x4 v[4]; float s[4];
#pragma unroll
      for (int k = 0; k < 4; ++k) { v[k] = *(const LAS f32x4*)(Cs + (wid * 8 + k0 + k) * 256 + lane * 4); s[k] = (v[k].x + v[k].y) + (v[k].z + v[k].w); }
#pragma unroll
      for (int k = 0; k < 4; ++k) s[k] = wave_sum_fast(s[k]);
#pragma unroll
      for (int k = 0; k < 4; ++k) { v[k] = v[k] - s[k] * (1.0f / 256.0f); s[k] = (v[k].x * v[k].x + v[k].y * v[k].y) + (v[k].z * v[k].z + v[k].w * v[k].w); }
#pragma unroll
      for (int k = 0; k < 4; ++k) s[k] = wave_sum_fast(s[k]);
#pragma unroll
      for (int k = 0; k < 4; ++k) { const float r = rsqrtf(s[k] * (1.0f / 256.0f) + EPS);
        float y[4];
#pragma unroll
        for (int e = 0; e < 4; ++e) { const float t = v[k][e] * r * gg[e] + bb[e]; y[e] = t * __builtin_amdgcn_rcpf(1.0f + __builtin_amdgcn_exp2f(-1.4426950408889634f * t)); }
        *(unsigned long long*)(MIX + (row0 + wid * 8 + k0 + k) * D + 512 + lane * 4) = (unsigned long long)pk2(y[0], y[1]) | ((unsigned long long)pk2(y[2], y[3]) << 32); } } }
    __syncthreads();
}

constexpr int P2_SCAL = 64 + 4 * 320;
__device__ __forceinline__ void p2_setup(Frame& F, const Args& A, int l) {
    int tid_ = mk_tid(F.wave); asm volatile("" : "+v"(tid_));
    const int tid = tid_, lane = tid & 63;
    LAS float* tab = (LAS float*)(F.lds + RING_OFF + att::TAB_OFF);
    const float* relb = A.in[I_RELB];
    if (tid < 64) tab[tid] = A.in[I_SUBG][l * 64 + tid];
    for (int i = tid; i < 4 * 320; i += NWAVES * 64) { const int h = i / 320, dist = 224 - (i % 320);
        tab[64 + i] = dist < 0 ? -1.0e30f : (relb[(int)REL_BUCKET_TAB[dist > 127 ? 127 : dist] * NH + h] - relb[31 * NH + h]) * att::LOG2E; }
    if (tid >= 448) {
        const int i = lane & 31; float s1 = A.in[I_LQ1][l * 32 + i] * A.in[I_LK1][l * 32 + i], s2 = A.in[I_LQ2][l * 32 + i] * A.in[I_LK2][l * 32 + i];
#pragma unroll
        for (int o = 1; o < 32; o <<= 1) { s1 += __shfl_xor(s1, o); s2 += __shfl_xor(s2, o); }
        const float lam_init = 0.8f - 0.6f * expf(-0.3f * (float)l);
        if (lane == 0) { tab[P2_SCAL] = expf(s1) - expf(s2) + lam_init; tab[P2_SCAL + 1] = 1.0f - lam_init; } }
    for (int i = tid; i < 31 * 64; i += NWAVES * 64) *(LAS f32x4*)(F.lds + RING_OFF + CONV_WS + i * 16) = *(const f32x4*)(A.in[I_CDWW] + (size_t)l * 31 * 256 + i * 4);
}
__device__ __forceinline__ void p2_fast(Frame& F, const Args& A, int l) {
    int tid_ = mk_tid(F.wave); asm volatile("" : "+v"(tid_));
    const int tid = tid_, lane = tid & 63, wid = __builtin_amdgcn_readfirstlane(tid >> 6);
    const unsigned char* Kimg = F.ws + WS_KIMG; const unsigned char* Vimg = F.ws + WS_VIMG; const bf16* Qn = (const bf16*)(F.ws + WS_QN);
    const float lam = ((const LAS float*)(F.lds + RING_OFF + att::TAB_OFF))[P2_SCAL], oml = ((const LAS float*)(F.lds + RING_OFF + att::TAB_OFF))[P2_SCAL + 1], negB = 0.f;
    for (int u = F.vcu; u < BATCH * NH * 8; u += F.G) {
        const int v = u & 255, bh = v >> 2, qb = u < 256 ? 7 - (v & 3) : (v & 3);
        att::attn_unit<0>(F.lds + RING_OFF, Qn, Kimg, Vimg, ((bf16*)(F.ws + WS_MIX)), A.in[I_RELB], A.in[I_SUBG] + l * 64, bh >> 2, bh & 3, qb, negB, lam, oml, tid, lane, wid);
    }
    for (int rep = 0; rep < A.conv_reps; ++rep)
    for (int k = 0; k < 2; ++k)
        conv_unit(F.lds + RING_OFF, ((bf16*)(F.ws + WS_ZC)), ((bf16*)(F.ws + WS_MIX)), A.in[I_SCONVW] + l * 3 * 256, A.in[I_CDWB] + l * 256, A.in[I_CLNG] + l * 256, A.in[I_CLNB] + l * 256, 2 * (F.vcu >> 5) + k, F.vcu & 31, tid, lane, wid);
}

constexpr int RSTAB_OFF = RING_BYTES;
__device__ __forceinline__ pg8::RstdSrc build_rstd(Frame& F, const pg8::StaticOrder& S, int& pmA, int& pmB) {
    pg8::Unit u; bool ok = true; pmA = -1; pmB = -1;
    for (int i = 0; S.next(i, u); ++i) { if (pmA < 0) pmA = u.pm; else if (u.pm != pmA) { if (pmB < 0) pmB = u.pm; else if (u.pm != pmB) ok = false; } }
    if (!ok && mk_tid(F.wave) == 0) __hip_atomic_store(F.ctl + CW_TMO, 0xBAD2u, RLX_AGENT);
    pg8::RstdSrc r; r.tab = (const LAS float*)(F.lds + RSTAB_OFF); r.pmA = pmA; return r;
}

__global__ void __launch_bounds__(NWAVES * 64, 2) fwd_kernel(Args args) {
    extern __shared__ __attribute__((aligned(16))) unsigned char lds[];
    Frame F;
    F.lds = (LAS unsigned char*)lds;
    F.MISC = (volatile LAS unsigned*)(F.lds + MISC_OFF);
    F.tid = threadIdx.x; F.lane = F.tid & 63; F.wave = __builtin_amdgcn_readfirstlane(F.tid >> 6);
    F.G = GRID_WG; { const int bx = blockIdx.x & (GRID_WG - 1);
      F.vcu = (F.G % 8 == 0) ? (bx % 8) * (F.G / 8) + bx / 8 : bx; }
    unsigned char* ws = args.ws; F.ws = ws;
    F.ctl = (gu32*)(ws + WS_CTL);
    for (int u = F.tid; u < (LDS_BYTES - LDSCTL_OFF) / 4; u += NWAVES * 64) ((LAS unsigned*)(F.lds + LDSCTL_OFF))[u] = 0u;
    __syncthreads();
    XcdBarrier bar; bar.bar = (unsigned*)(F.ctl + CW_BAR); bar.x = 0; bar.st = nullptr;
    if (!MK_PER_PHASE) { bar = xcd_barrier_post((unsigned*)(F.ctl + CW_BAR), F.MISC + 8); if (threadIdx.x == 0) (void)xb_add((unsigned*)F.ctl + GB_CEN(blockIdx.x & 7u, bar.x), 1u); }
    bar.wave = F.wave;
    const int lo = args.ph_lo, hi = args.ph_hi;
#define IN(k) (lo <= (k) && (k) < hi)
#define BOTH(k) (IN(k) && IN((k) + 1))
#define GROUP_BAR() do { if (MK_PER_PHASE) { if (F.tid == 0) __hip_atomic_store(F.ctl + CW_TMO, 0xBADBA0u, RLX_AGENT); } else { group_barrier((unsigned*)F.ctl, (unsigned*)(F.ctl + CW_BAR), F.MISC + 10, F.wave); } } while (0)
#define GRID_BAR() do { if (MK_PER_PHASE) { if (F.tid == 0) __hip_atomic_store(F.ctl + CW_TMO, 0xBADBA0u, RLX_AGENT); } else { xcd_barrier(bar); } } while (0)

    if (IN(0)) { p0_prologue(F, args);
        if (BOTH(0)) GRID_BAR(); }
    for (int l = 0; l < DEPTH; ++l) {
        const int p = 1 + 5 * l;
        if (IN(p)) {
            pg8::Gemm g{((bf16*)(F.ws + WS_XB)), w_ptr(F, l, WOFF_IN), M, DIN, D}; pg8::StaticOrder S; S.init(M, DIN, F.G, (int)(blockIdx.x & (GRID_WG - 1))); S.lim = 4 * F.G;
            int pmA, pmB; pg8::EpiIn E{F.ws, build_rstd(F, S, pmA, pmB), args.in[I_QNG] + l * 32, args.in[I_KNG] + l * 32};
            pg8::gemm_phase<pg8::EpiIn, pg8::StaticOrder, PG8_ALIGN, PG8_SP2, false, true>(F.lds + RING_OFF, g, S, E, F.wave, (const float*)(F.ws + WS_PART), (LAS float*)(F.lds + RSTAB_OFF), pmA, pmB);
            { pg8::TailOrder T{(int)(blockIdx.x & (GRID_WG - 1))}; pg8::EpiInTail ET{F.ws, args.in[I_KNG] + l * 32};
              pg8::gemm_phase<pg8::EpiInTail, pg8::TailOrder, PG8_ALIGN, PG8_SP2, true>(F.lds + RING_OFF, g, T, ET, F.wave); }
            if (BOTH(p)) { p2_setup(F, args, l); GROUP_BAR(); }
        }
        if (IN(p + 1)) {
            if (!IN(p)) { p2_setup(F, args, l); __syncthreads(); }
            p2_fast(F, args, l);
            if (BOTH(p + 1)) GROUP_BAR();
        }
#pragma nounroll
        for (int s3 = 0; s3 < 3; ++s3) {
            const int ph = p + 2 + s3;
            if (!IN(ph)) continue;
            if (s3 == 1) {
                pg8::Gemm g{((bf16*)(F.ws + WS_XB)), w_ptr(F, l, WOFF_GU), M, NGU, D}; pg8::StaticOrder S; S.init(M, NGU, F.G, (int)(blockIdx.x & (GRID_WG - 1)));
                int pmA, pmB; pg8::EpiGLU E{((bf16*)(F.ws + WS_ACT)), DFF, build_rstd(F, S, pmA, pmB)};
                pg8::gemm_phase<pg8::EpiGLU, pg8::StaticOrder, PG8_ALIGN, PG8_SP2, false, true>(F.lds + RING_OFF, g, S, E, F.wave, (const float*)(F.ws + WS_PART), (LAS float*)(F.lds + RSTAB_OFF), pmA, pmB);
            } else {
                const bool dn = s3 == 2;
                pg8::Gemm g{(bf16*)(F.ws + (dn ? WS_ACT : WS_MIX)), w_ptr(F, l, dn ? WOFF_DN : WOFF_OUT), M, D, dn ? DFF : D}; pg8::StaticOrder S; S.init(M, D, F.G, (int)(blockIdx.x & (GRID_WG - 1))); S.rev = dn ? 1 : 0;
                pg8::EpiRes E{F.ws, (dn && l == DEPTH - 1) ? args.out : nullptr};
                pg8::gemm_phase<pg8::EpiRes, pg8::StaticOrder, PG8_ALIGN, PG8_SP2>(F.lds + RING_OFF, g, S, E, F.wave);
            }
            if (BOTH(ph)) GROUP_BAR();
        }
    }
#undef IN
#undef BOTH
}

extern "C" void kernel_launch(void* const* d_in, const int* in_sizes, int n_in, void* d_out, int out_size, void* d_ws, size_t ws_size, hipStream_t stream) {
    static int grid = 0;
    if (grid == 0) {
        if (n_in != N_IN || in_sizes[0] != M * D || out_size != M * D || ws_size < WS_END) {
            fprintf(stderr, "kernel_launch: built for %d inputs, x/out of %d floats, >= %zu bytes of workspace; got n_in %d, in0 %d, out %d, ws %zu; nothing launched\n", N_IN, M * D, (size_t)WS_END, n_in, n_in > 0 ? in_sizes[0] : -1, out_size, ws_size);
            grid = -1; return; }
        int dev = 0, cus = 0, per_cu = 0;
        if (hipGetDevice(&dev) != hipSuccess || hipDeviceGetAttribute(&cus, hipDeviceAttributeMultiprocessorCount, dev) != hipSuccess) { fprintf(stderr, "kernel_launch: device query failed\n"); grid = -1; return; }
        if (hipFuncSetAttribute((const void*)fwd_kernel, hipFuncAttributeMaxDynamicSharedMemorySize, LDS_BYTES) != hipSuccess) { fprintf(stderr, "kernel_launch: hipFuncSetAttribute failed\n"); grid = -1; return; }
        if (hipOccupancyMaxActiveBlocksPerMultiprocessor(&per_cu, (const void*)fwd_kernel, NWAVES * 64, LDS_BYTES) != hipSuccess || per_cu < 1) {
            fprintf(stderr, "kernel_launch: occupancy query reports %d workgroups per CU; nothing launched\n", per_cu); (void)hipGetLastError(); grid = -1; return; }
        if (cus < 256) { fprintf(stderr, "kernel_launch: built for a 256-CU device (got %d CUs); nothing launched\n", cus); grid = -1; return; }
        grid = GRID_WG;
    }
    if (grid < 0) return;
    if (hipMemsetAsync((char*)d_ws + WS_CTL, 0, CTL_ZERO_BYTES, stream) != hipSuccess) { fprintf(stderr, "kernel_launch: memset failed\n"); return; }
    Args a{};
    for (int i = 0; i < N_IN; ++i) a.in[i] = (const float*)d_in[i];
    a.out = (float*)d_out; a.ws = (unsigned char*)d_ws;
    a.att_reps = 1; a.conv_reps = 1;
#if MK_PER_PHASE
    for (int p = 0; p < NPH; ++p) { a.ph_lo = p; a.ph_hi = p + 1; hipLaunchKernelGGL(fwd_kernel, dim3(grid), dim3(NWAVES * 64), LDS_BYTES, stream, a); }
#else
    a.ph_lo = 0; a.ph_hi = NPH;
    hipLaunchKernelGGL(fwd_kernel, dim3(grid), dim3(NWAVES * 64), LDS_BYTES, stream, a);
#endif
    const hipError_t le = hipPeekAtLastError();
    if (le != hipSuccess) fprintf(stderr, "kernel_launch: launch failed: %s\n", hipGetErrorName(le));
}
```
